# Optimizing an MI355X kernel written in HIP

```python
import math
import jax, jax.numpy as jnp
from jax import lax
import numpy as np

D_MODEL = 2048
BATCH = 4
SEQ = 4096
DEPTH = 1

SSD_HEADS = 32
SSD_HEAD_DIM = 64
SSD_DIM = SSD_HEADS * SSD_HEAD_DIM
SSD_GROUPS = 4
SSD_HEADS_PER_GROUP = SSD_HEADS // SSD_GROUPS
SSD_STATE = 128
SSD_CHUNK = 128
CONV_WIDTH = 4
CONV_DIM = SSD_DIM + 2 * SSD_GROUPS * SSD_STATE
FOX_HEADS = 16
FOX_HEAD_DIM = 128
FOX_DIM = FOX_HEADS * FOX_HEAD_DIM
Q_BLOCK = 128
N_BRANCH = 2
IN_PROJ_DIM = SSD_DIM + CONV_DIM + SSD_HEADS + 3 * FOX_DIM + FOX_HEADS + N_BRANCH * D_MODEL
N_GROUPS = 8
EXPERTS_PER_GROUP = 8
N_EXPERTS = N_GROUPS * EXPERTS_PER_GROUP
TOP_K_IN_GROUP = 2
D_EXPERT = 512
ROW_BLOCK = 128
EPS = 1e-6

kernel_name = "hybrid_ssd_fox_hiermoe_block"


def rmsnorm(x, w):
    xf = x.astype(jnp.float32)
    xf = xf * lax.rsqrt(jnp.mean(xf * xf, axis=-1, keepdims=True) + EPS)
    return (xf * w.astype(jnp.float32)).astype(x.dtype)


def causal_depthwise_conv(x, w, b):
    c = x.shape[-1]
    y = lax.conv_general_dilated(x, w[:, None, :].astype(x.dtype), window_strides=(1,),
                                 padding=[(CONV_WIDTH - 1, 0)],
                                 dimension_numbers=("NWC", "WIO", "NWC"),
                                 feature_group_count=c)
    return y + b.astype(x.dtype)


def ssd_mixer(z, xbc, dt_raw, conv_w, conv_b, dt_bias, a_log, d_skip, norm_w):
    out_dtype = z.dtype
    bsz, s, _ = xbc.shape
    nc = s // SSD_CHUNK
    g, e, p, n, l = SSD_GROUPS, SSD_HEADS_PER_GROUP, SSD_HEAD_DIM, SSD_STATE, SSD_CHUNK
    xbc = jax.nn.silu(causal_depthwise_conv(xbc, conv_w, conv_b)).astype(jnp.float32)
    xs = xbc[..., :SSD_DIM]
    bm = xbc[..., SSD_DIM:SSD_DIM + g * n].reshape(bsz, nc, l, g, n)
    cm = xbc[..., SSD_DIM + g * n:].reshape(bsz, nc, l, g, n)
    dt = jax.nn.softplus(dt_raw.astype(jnp.float32) + dt_bias.astype(jnp.float32))
    a = -jnp.exp(a_log.astype(jnp.float32))
    a_cs = jnp.cumsum((dt * a).reshape(bsz, nc, l, SSD_HEADS), axis=2)
    x_dt = (xs.reshape(bsz, s, SSD_HEADS, p) * dt[..., None]).reshape(bsz, nc, l, g, e, p)
    seg = a_cs[:, :, :, None, :] - a_cs[:, :, None, :, :]
    causal = jnp.tril(jnp.ones((l, l), dtype=bool))[None, None, :, :, None]
    lmat = jnp.exp(jnp.where(causal, seg, -jnp.inf)).reshape(bsz, nc, l, l, g, e)
    cb = jnp.einsum('bclgn,bcsgn->bclsg', cm, bm)
    y_diag = jnp.einsum('bclsge,bcsgep->bclgep', cb[..., None] * lmat, x_dt)
    decay_states = jnp.exp(a_cs[:, :, -1:, :] - a_cs).reshape(bsz, nc, l, g, e)
    states = jnp.einsum('bclgn,bclgep->bcgepn', bm, x_dt * decay_states[..., None])
    chunk_decay = jnp.exp(a_cs[:, :, -1, :]).reshape(bsz, nc, g, e)

    def step(carry, inp):
        st, dec = inp
        return carry * dec[..., None, None] + st, carry

    init = jnp.zeros((bsz, g, e, p, n), jnp.float32)
    _, prev = lax.scan(step, init, (jnp.moveaxis(states, 1, 0), jnp.moveaxis(chunk_decay, 1, 0)))
    prev = jnp.moveaxis(prev, 0, 1)
    y_off = jnp.einsum('bclgn,bcgepn->bclgep', cm, prev) * jnp.exp(a_cs).reshape(bsz, nc, l, g, e)[..., None]
    y = (y_diag + y_off).reshape(bsz, s, SSD_HEADS, p)
    y = y + d_skip.astype(jnp.float32)[:, None] * xs.reshape(bsz, s, SSD_HEADS, p)
    y = y.reshape(bsz, s, SSD_DIM) * jax.nn.silu(z.astype(jnp.float32))
    return rmsnorm(y, norm_w).astype(out_dtype)


def forgetting_attention(q, k, v, f_logits, f_bias):
    bsz, s, _ = q.shape
    h, d = FOX_HEADS, FOX_HEAD_DIM
    q = q.reshape(bsz, s, h, d).transpose(0, 2, 1, 3)
    k = k.reshape(bsz, s, h, d).transpose(0, 2, 1, 3)
    v = v.reshape(bsz, s, h, d).transpose(0, 2, 1, 3)
    log_f = jax.nn.log_sigmoid(f_logits.astype(jnp.float32) + f_bias.astype(jnp.float32))
    cum = jnp.cumsum(log_f, axis=1).transpose(0, 2, 1)
    scale = 1.0 / math.sqrt(d)
    key_pos = jnp.arange(s)

    def block(i):
        start = i * Q_BLOCK
        qb = lax.dynamic_slice_in_dim(q, start, Q_BLOCK, axis=2)
        cq = lax.dynamic_slice_in_dim(cum, start, Q_BLOCK, axis=2)
        logits = jnp.einsum('bhqd,bhkd->bhqk', qb, k).astype(jnp.float32) * scale
        logits = logits + cq[..., :, None] - cum[:, :, None, :]
        mask = key_pos[None, :] <= (start + jnp.arange(Q_BLOCK))[:, None]
        probs = jax.nn.softmax(jnp.where(mask, logits, -jnp.inf), axis=-1)
        return jnp.einsum('bhqk,bhkd->bhqd', probs.astype(v.dtype), v)

    out = lax.map(block, jnp.arange(s // Q_BLOCK))
    return out.transpose(1, 0, 3, 2, 4).reshape(bsz, s, FOX_DIM)


def hierarchical_moe(u, w_rg, b_rg, w_re, b_re, w_gate, w_up, w_down):
    bsz, s, d = u.shape
    t = bsz * s
    uf = u.reshape(t, d)
    g_prob = jax.nn.softmax((uf @ w_rg).astype(jnp.float32) + b_rg.astype(jnp.float32), axis=-1)
    g_p, g_idx = lax.top_k(g_prob, 1)
    e_logits = ((uf @ w_re).astype(jnp.float32) + b_re.astype(jnp.float32)).reshape(t, N_GROUPS, EXPERTS_PER_GROUP)
    e_in = jnp.take_along_axis(e_logits, g_idx[:, :, None], axis=1)[:, 0]
    e_p, e_loc = lax.top_k(jax.nn.softmax(e_in, axis=-1), TOP_K_IN_GROUP)
    weights = g_p * (e_p / jnp.sum(e_p, axis=-1, keepdims=True))
    expert_idx = g_idx * EXPERTS_PER_GROUP + e_loc
    tk = t * TOP_K_IN_GROUP
    n_blocks = (tk + ROW_BLOCK - 1) // ROW_BLOCK + N_EXPERTS
    n_rows = n_blocks * ROW_BLOCK
    e_flat = expert_idx.reshape(tk)
    w_flat = weights.reshape(tk)
    tok_flat = jnp.repeat(jnp.arange(t, dtype=jnp.int32), TOP_K_IN_GROUP)
    order = jnp.argsort(e_flat)
    e_sorted = e_flat[order]
    counts = jnp.bincount(e_flat, length=N_EXPERTS)
    start = jnp.cumsum(counts) - counts
    padded = ((counts + ROW_BLOCK - 1) // ROW_BLOCK) * ROW_BLOCK
    pend = jnp.cumsum(padded)
    pstart = pend - padded
    dest = pstart[e_sorted] + (jnp.arange(tk) - start[e_sorted])
    row_tok = jnp.zeros((n_rows,), jnp.int32).at[dest].set(tok_flat[order])
    row_w = jnp.zeros((n_rows,), jnp.float32).at[dest].set(w_flat[order])
    block_expert = jnp.clip(jnp.searchsorted(pend, jnp.arange(n_blocks) * ROW_BLOCK, side='right'),
                            0, N_EXPERTS - 1).astype(jnp.int32)
    xs = uf[row_tok].reshape(n_blocks, ROW_BLOCK, d)

    def expert_block(args):
        xb, ex = args
        hdn = jax.nn.silu(xb @ jnp.take(w_gate, ex, axis=0)) * (xb @ jnp.take(w_up, ex, axis=0))
        return hdn @ jnp.take(w_down, ex, axis=0)

    y_rows = lax.map(expert_block, (xs, block_expert)).reshape(n_rows, d)
    y_rows = y_rows * row_w[:, None].astype(y_rows.dtype)
    out = jax.ops.segment_sum(y_rows, row_tok, num_segments=t)
    return out.reshape(bsz, s, d)


def setup_inputs(seed: int = 0) -> dict:
    key = jax.random.key(seed)
    ks = jax.random.split(key, 24)
    f32 = jnp.float32
    nrm = lambda k, shape, sc: jax.random.normal(k, shape, f32) * sc
    gain = lambda k, shape: 1.0 + 0.02 * jax.random.normal(k, shape, f32)
    dt0 = jnp.exp(jax.random.uniform(ks[5], (DEPTH, SSD_HEADS), f32, math.log(1e-3), math.log(1e-1)))
    return {
        "x": jax.random.normal(ks[0], (BATCH, SEQ, D_MODEL), f32),
        "norm_mix_w": gain(ks[1], (DEPTH, D_MODEL)),
        "w_in": nrm(ks[2], (DEPTH, D_MODEL, IN_PROJ_DIM), D_MODEL ** -0.5),
        "conv_w": nrm(ks[3], (DEPTH, CONV_WIDTH, CONV_DIM), CONV_WIDTH ** -0.5),
        "conv_b": nrm(ks[4], (DEPTH, CONV_DIM), 0.02),
        "dt_bias": dt0 + jnp.log(-jnp.expm1(-dt0)),
        "a_log": jnp.log(jax.random.uniform(ks[6], (DEPTH, SSD_HEADS), f32, 1.0, 16.0)),
        "d_skip": gain(ks[7], (DEPTH, SSD_HEADS)),
        "ssd_norm_w": gain(ks[8], (DEPTH, SSD_DIM)),
        "fox_f_bias": jax.random.uniform(ks[9], (DEPTH, FOX_HEADS), f32, 2.0, 5.0),
        "w_proj_ssd": nrm(ks[10], (DEPTH, SSD_DIM, D_MODEL), SSD_DIM ** -0.5),
        "w_proj_fox": nrm(ks[11], (DEPTH, FOX_DIM, D_MODEL), FOX_DIM ** -0.5),
        "w_out": nrm(ks[12], (DEPTH, D_MODEL, D_MODEL), D_MODEL ** -0.5),
        "norm_moe_w": gain(ks[13], (DEPTH, D_MODEL)),
        "w_router_group": nrm(ks[14], (DEPTH, D_MODEL, N_GROUPS), D_MODEL ** -0.5),
        "b_router_group": nrm(ks[15], (DEPTH, N_GROUPS), 0.01),
        "w_router_expert": nrm(ks[16], (DEPTH, D_MODEL, N_EXPERTS), D_MODEL ** -0.5),
        "b_router_expert": nrm(ks[17], (DEPTH, N_EXPERTS), 0.01),
        "w_gate_exp": nrm(ks[18], (DEPTH, N_EXPERTS, D_MODEL, D_EXPERT), D_MODEL ** -0.5),
        "w_up_exp": nrm(ks[19], (DEPTH, N_EXPERTS, D_MODEL, D_EXPERT), D_MODEL ** -0.5),
        "w_down_exp": nrm(ks[20], (DEPTH, N_EXPERTS, D_EXPERT, D_MODEL), D_EXPERT ** -0.5),
        "norm_final_w": gain(ks[21], (D_MODEL,)),
    }


def reference(x, norm_mix_w, w_in, conv_w, conv_b, dt_bias, a_log, d_skip, ssd_norm_w, fox_f_bias,
              w_proj_ssd, w_proj_fox, w_out, norm_moe_w, w_router_group, b_router_group,
              w_router_expert, b_router_expert, w_gate_exp, w_up_exp, w_down_exp, norm_final_w):
    sizes = (SSD_DIM, CONV_DIM, SSD_HEADS, FOX_DIM, FOX_DIM, FOX_DIM, FOX_HEADS, N_BRANCH * D_MODEL)
    offsets = [int(o) for o in np.cumsum(sizes)[:-1]]
    h = x
    for layer in range(DEPTH):
        u = rmsnorm(h, norm_mix_w[layer])
        proj = u @ w_in[layer]
        z, xbc, dt_raw, q, k, v, f_logits, gate_logits = jnp.split(proj, offsets, axis=-1)
        y_ssd = ssd_mixer(z, xbc, dt_raw, conv_w[layer], conv_b[layer], dt_bias[layer],
                          a_log[layer], d_skip[layer], ssd_norm_w[layer])
        y_fox = forgetting_attention(q, k, v, f_logits, fox_f_bias[layer])
        gates = jax.nn.sigmoid(gate_logits.astype(jnp.float32)).astype(h.dtype)
        g_ssd, g_fox = jnp.split(gates, N_BRANCH, axis=-1)
        mixed = g_ssd * (y_ssd @ w_proj_ssd[layer]) + g_fox * (y_fox @ w_proj_fox[layer])
        h = h + mixed @ w_out[layer]
        u2 = rmsnorm(h, norm_moe_w[layer])
        h = h + hierarchical_moe(u2, w_router_group[layer], b_router_group[layer],
                                 w_router_expert[layer], b_router_expert[layer],
                                 w_gate_exp[layer], w_up_exp[layer], w_down_exp[layer])
    return rmsnorm(h, norm_final_w)
```

```cpp
#include <hip/hip_runtime.h>
#include <cstdio>
#include <cstdint>

#ifndef N_LAUNCH_MODE
#define N_LAUNCH_MODE 1
#endif

#define GAS __attribute__((address_space(1)))
#define LAS __attribute__((address_space(3)))
typedef unsigned short bf16;
typedef unsigned v4u __attribute__((ext_vector_type(4)));
typedef unsigned v2u __attribute__((ext_vector_type(2)));
typedef float f32x4 __attribute__((ext_vector_type(4)));
typedef float f32x16 __attribute__((ext_vector_type(16)));
typedef short bf16x8 __attribute__((ext_vector_type(8)));
typedef short s16x4 __attribute__((ext_vector_type(4)));
#define RLX_AGENT __ATOMIC_RELAXED, __HIP_MEMORY_SCOPE_AGENT
#define LDS_WAIT() asm volatile("s_waitcnt lgkmcnt(0)" ::: "memory")
#define VM_WAIT() asm volatile("s_waitcnt vmcnt(0)" ::: "memory")
#define LDS_BARRIER() do { asm volatile("s_waitcnt lgkmcnt(0)" ::: "memory"); __builtin_amdgcn_s_barrier(); asm volatile("" ::: "memory"); } while (0)

constexpr int T = 16384, DM = 2048, SEQ = 4096, NB = 4;
constexpr int NPROJ = 15408, NPROJ_P = 15360, WIN_ROWS = 15408;
constexpr int SSD_H = 32, SSD_P = 64, SSD_N = 128, SSD_G = 4, CONVD = 3072;
constexpr int FOX_H = 16;
constexpr int NEXP = 64, DEXP = 512, MAXROWS = 49152;
constexpr float EPS = 1e-6f;
constexpr int SRC_Z = 0, SRC_XBC = 2048, SRC_DT = 5120, SRC_QKV = 5152, SRC_F = 11296, SRC_GATE = 11312;
constexpr int DST_Z = 0, DST_XBC = 2048, DST_QKV = 5120, DST_GATE = 11264, DST_SMALL = 15360;

constexpr size_t MiB = 1u << 20;
constexpr size_t WS_CTL = 0, CTL_ZERO_BYTES = 1 * MiB;
constexpr size_t WS_TAB = 1 * MiB;
constexpr size_t WS_DT = 2 * MiB;
constexpr size_t WS_CUM = 4 * MiB;
constexpr size_t WS_WR = 11 * MiB;
constexpr size_t WS_WAB = 12 * MiB;
constexpr size_t WS_WO = 28 * MiB;
constexpr size_t WS_Q = 36 * MiB, WS_K = 100 * MiB, WS_V = 164 * MiB;
constexpr size_t WS_H = 36 * MiB;
constexpr size_t ARENA = 228 * MiB;
constexpr size_t WS_WIN = ARENA;
constexpr size_t WS_XN = 289 * MiB;
constexpr size_t WS_XBC = 353 * MiB;
constexpr size_t WS_Z = 449 * MiB;
constexpr size_t WS_G = 513 * MiB;
constexpr size_t WS_XC = 641 * MiB;
constexpr size_t WS_AB = 289 * MiB;
constexpr size_t WS_MIX = 641 * MiB;
constexpr size_t WS_WGU = 737 * MiB;
constexpr size_t WS_WDA = 228 * MiB;
constexpr size_t WS_WDB = 289 * MiB;
constexpr int WD_SPLIT = 30;
constexpr size_t WS_U2 = 612 * MiB;
constexpr size_t WS_HDN = 676 * MiB;
constexpr size_t WS_YM = 737 * MiB;
constexpr size_t WS_XN8 = 870 * MiB;
constexpr size_t WS_WQKV8 = 902 * MiB;
constexpr float XN_SCALE = 16.f;
constexpr size_t WS_WB8 = 865 * MiB;
constexpr size_t WS_PART = 870 * MiB;
constexpr size_t WS_YF8 = 934 * MiB;
constexpr float YF_SCALE = 32.f;
constexpr size_t WS_SS = 993 * MiB;
constexpr size_t WS_DTF = 997 * MiB;
constexpr size_t WS_END = 1005 * MiB;
constexpr int CW_CNT = 64;
constexpr int CW_BAR = 4096;
constexpr int CW_AQ = 512, CW_CQ = 1536, CW_QM = 8192, CW_KM = 9216;
constexpr size_t TAB_E = 0, TAB_W = 128 * 1024, TAB_RANK = 256 * 1024, TAB_ROW = 384 * 1024, TAB_TILE = 512 * 1024, TAB_ROWTOK = 768 * 1024;

constexpr int RING_BYTES = 131072;
constexpr int LDSCTL_OFF = 153600, MISC_OFF = LDSCTL_OFF + 320;
constexpr int LTAB_OFF = 147456;
constexpr int LDS_BYTES = 155648;

__device__ __forceinline__ unsigned f2bf(float f) { unsigned u = __builtin_bit_cast(unsigned, f); return (u + 0x7fffu + ((u >> 16) & 1u)) >> 16; }
__device__ __forceinline__ unsigned pk2(float lo, float hi) { return f2bf(lo) | (f2bf(hi) << 16); }
typedef float f32x2_t __attribute__((ext_vector_type(2))); typedef __bf16 bf16x2_t __attribute__((ext_vector_type(2)));
__device__ __forceinline__ unsigned cvt2(float lo, float hi) { f32x2_t v = {lo, hi}; bf16x2_t b = __builtin_convertvector(v, bf16x2_t); return __builtin_bit_cast(unsigned, b); }
__device__ __forceinline__ unsigned cvt_fp8x2(float a, float b, unsigned old, bool hi) {
    a = __builtin_fminf(__builtin_fmaxf(a, -448.f), 448.f); b = __builtin_fminf(__builtin_fmaxf(b, -448.f), 448.f);
    return hi ? (unsigned)__builtin_amdgcn_cvt_pk_fp8_f32(a, b, (int)old, true) : (unsigned)__builtin_amdgcn_cvt_pk_fp8_f32(a, b, (int)old, false); }
typedef float f32x2v_t __attribute__((ext_vector_type(2)));
__device__ __forceinline__ f32x4 fp8x4_to_f32(unsigned w) { const f32x2v_t lo = __builtin_amdgcn_cvt_pk_f32_fp8((int)w, false), hi = __builtin_amdgcn_cvt_pk_f32_fp8((int)w, true); return (f32x4){lo[0], lo[1], hi[0], hi[1]}; }
__device__ __forceinline__ unsigned cvt_fp8x4(float a, float b, float c, float d) { unsigned w = cvt_fp8x2(a, b, 0u, false); return cvt_fp8x2(c, d, w, true); }
__device__ __forceinline__ float bf2f(unsigned b) { return __uint_as_float(b << 16); }
__device__ __forceinline__ float bflo(unsigned w) { return __uint_as_float(w << 16); }
__device__ __forceinline__ float bfhi(unsigned w) { return __uint_as_float(w & 0xffff0000u); }
__device__ __forceinline__ float wave_sum(float v) {
#pragma unroll
    for (int o = 1; o < 64; o <<= 1) v += __shfl_xor(v, o);
    return v;
}
#define DPP_ADD(v, ctrl, rmask, bctl) ((v) + __builtin_bit_cast(float, __builtin_amdgcn_update_dpp(0, __builtin_bit_cast(int, (v)), (ctrl), (rmask), 0xF, (bctl))))
__device__ __forceinline__ float row16_sum(float v) {
    v = DPP_ADD(v, 0xB1, 0xF, true);
    v = DPP_ADD(v, 0x4E, 0xF, true);
    v = DPP_ADD(v, 0x141, 0xF, true);
    v = DPP_ADD(v, 0x140, 0xF, true);
    return v;
}
__device__ __forceinline__ float wave_incl_scan(float v) {
    v = DPP_ADD(v, 0x111, 0xF, false);
    v = DPP_ADD(v, 0x112, 0xF, false);
    v = DPP_ADD(v, 0x114, 0xF, false);
    v = DPP_ADD(v, 0x118, 0xF, false);
    v = DPP_ADD(v, 0x142, 0xA, false);
    v = DPP_ADD(v, 0x143, 0xC, false);
    return v;
}
__device__ __forceinline__ float sigmoidf_(float x) { return __builtin_amdgcn_rcpf(1.f + __expf(-x)); }
__device__ __forceinline__ float siluf_(float x) { return x * sigmoidf_(x); }
__device__ __forceinline__ unsigned ld_ctl(const unsigned* p) { return __hip_atomic_load(p, RLX_AGENT); }

namespace pg8 {
#define PG8_LAS __attribute__((address_space(3)))
constexpr int BM = 256, BK = 64, HALF = 128, HTB = HALF * BK * 2, STAGE_BYTES = 8 * HTB, NXCD = 8, WGM = 2;
__host__ __device__ __forceinline__ int lds_byte(int r, int c) { const int st = (r >> 4) * 2 + (c >> 5), rr = r & 15, cc = c & 31, ob = rr * 64 + cc * 2; return st * 1024 + (ob ^ (((ob >> 9) & 1) << 5)); }
__host__ __device__ __forceinline__ void stage_rc(int b, int& R, int& C) { const int st = b / 1024, sb = b % 1024, swz = sb ^ (((sb >> 9) & 1) << 5); R = (st >> 1) * 16 + swz / 64; C = (st & 1) * 32 + (swz % 64) / 2; }
__host__ __device__ __forceinline__ int perm32(int rho) { const int n = rho >> 4, i = rho & 15; return 8 * (i >> 2) + 4 * n + (i & 3); }
struct Unit { const char* A; const char* B; const int* rows; int pm, pn, aux; };
struct Shape { int K, lda, ldb; };
__device__ __forceinline__ void tile_of(int L, int nM, int nN, int& pm, int& pn) {
    const int nwg = nM * nN; int wgid = L; { const int q = nwg / NXCD, r = nwg % NXCD, xcd = wgid % NXCD, off = wgid / NXCD; wgid = (xcd < r ? xcd * (q + 1) : r * (q + 1) + (xcd - r) * q) + off; }
    const int nig = WGM * nN, gid = wgid / nig, fm = gid * WGM, gsz = (nM - fm) < WGM ? (nM - fm) : WGM;
    pm = fm + ((wgid % nig) % gsz); pn = (wgid % nig) / gsz;
}
__device__ __forceinline__ unsigned cvt_pk_bf16(float lo, float hi) { unsigned r; asm volatile("v_cvt_pk_bf16_f32 %0, %1, %2" : "=v"(r) : "v"(lo), "v"(hi)); return r; }

template <class Epi, class Sched, bool ALIGN_EPI, bool GATHER = false, bool FP8 = false>
__device__ __forceinline__ void gemm_phase(PG8_LAS unsigned char* lds, const Shape g, const Sched& S, const Epi& E) {
    const int tid = threadIdx.x, wid = __builtin_amdgcn_readfirstlane(tid >> 6), lane = tid & 63, wr = wid >> 2, wc = wid & 3, fr = lane & 15, fq = lane >> 4;
    const int K = g.K, nt = K / BK;
    unsigned voffA[2], voffB[2];
#pragma unroll
    for (int i = 0; i < 2; ++i) { int R, C; stage_rc(tid * 16 + i * 8192, R, C); const int Rb = Epi::PERM ? ((R & ~31) + perm32(R & 31)) : R;
        voffA[i] = (unsigned)(R * g.lda + C) * 2u; voffB[i] = (unsigned)(Rb * g.ldb + C) * 2u; }
    const size_t kstep = (size_t)(BK * 2);
    const size_t hstepA = (size_t)HALF * g.lda * 2, hstepB = (size_t)HALF * g.ldb * 2;
    const unsigned ldsw = (unsigned)wid * 1024u;
    const int aoff = lds_byte(wr * 64 + fr, fq * 8), boff = lds_byte(wc * 32 + fr, fq * 8);
#define PG8_SA(b, h) (((b) * 2 + (h)) * HTB)
#define PG8_SB(b, h) ((4 + (b) * 2 + (h)) * HTB)
#define PG8_STAGE(bufoff, gbase, voff) do { _Pragma("unroll") for (int _i = 0; _i < 2; ++_i) \
        __builtin_amdgcn_global_load_lds((const unsigned*)((const char*)(gbase) + (voff)[_i]), (PG8_LAS unsigned*)(lds + (bufoff) + ldsw + _i * 8192), 16, 0, 0); } while (0)
#define PG8_STAGE_A(bufoff, kptr, hf, vv) do { if constexpr (GATHER) { PG8_STAGE(bufoff, kptr, (vv)[hf]); } else { PG8_STAGE(bufoff, (kptr) + (hf) * hstepA, voffA); } } while (0)
#define PG8_GATHER_STORE(par, rowsp) do { unsigned d_[2][2]; _Pragma("unroll") for (int hf_ = 0; hf_ < 2; ++hf_) _Pragma("unroll") for (int i_ = 0; i_ < 2; ++i_) { int R_, C_; stage_rc(tid * 16 + i_ * 8192, R_, C_); \
        int tk_ = (rowsp)[hf_ * HALF + R_]; tk_ = tk_ < 0 ? 0 : tk_; d_[hf_][i_] = (unsigned)tk_ * (unsigned)(g.lda * 2) + (unsigned)(C_ * 2); } \
        gslot[(par) * 512] = (v4u){d_[0][0], d_[0][1], d_[1][0], d_[1][1]}; } while (0)
#define PG8_LDA(dst, b, h) do { _Pragma("unroll") for (int m = 0; m < 4; ++m) _Pragma("unroll") for (int k = 0; k < 2; ++k) dst[m][k] = *(const PG8_LAS bf16x8*)(lds + PG8_SA(b, h) + aoff + m * 2048 + k * 1024); } while (0)
#define PG8_LDB(dst, b, h) do { _Pragma("unroll") for (int n = 0; n < 2; ++n) _Pragma("unroll") for (int k = 0; k < 2; ++k) dst[n][k] = *(const PG8_LAS bf16x8*)(lds + PG8_SB(b, h) + boff + n * 2048 + k * 1024); } while (0)
#define PG8_MMA(ai, bj, At, Bt) do { __builtin_amdgcn_s_setprio(1); _Pragma("unroll") for (int m = 0; m < 4; ++m) _Pragma("unroll") for (int n = 0; n < 2; ++n) { \
        if constexpr (FP8) { typedef int v8i_ __attribute__((ext_vector_type(8))); typedef int v4i_ __attribute__((ext_vector_type(4))); \
            const v4i_ b0_ = __builtin_bit_cast(v4i_, Bt[n][0]), b1_ = __builtin_bit_cast(v4i_, Bt[n][1]), a0_ = __builtin_bit_cast(v4i_, At[m][0]), a1_ = __builtin_bit_cast(v4i_, At[m][1]); \
            const v8i_ bb_ = {b0_[0], b0_[1], b0_[2], b0_[3], b1_[0], b1_[1], b1_[2], b1_[3]}, aa_ = {a0_[0], a0_[1], a0_[2], a0_[3], a1_[0], a1_[1], a1_[2], a1_[3]}; \
              \
            asm volatile("s_nop 1\n\tv_mfma_scale_f32_16x16x128_f8f6f4 %0, %1, %2, %0, %3, %3 op_sel_hi:[0,0,0]" : "+v"(acc[ai][bj][m][n]) : "v"(bb_), "v"(aa_), "v"(0x7F7F7F7F)); } \
        else { _Pragma("unroll") for (int k = 0; k < 2; ++k) acc[ai][bj][m][n] = __builtin_amdgcn_mfma_f32_16x16x32_bf16(Bt[n][k], At[m][k], acc[ai][bj][m][n], 0, 0, 0); } } \
        __builtin_amdgcn_s_setprio(0); } while (0)
#define PG8_WAIT_V(n) asm volatile("s_waitcnt vmcnt(" #n ")" ::: "memory")
#define PG8_WAIT_L(n) asm volatile("s_waitcnt lgkmcnt(" #n ")" ::: "memory")
#define PG8_BAR __builtin_amdgcn_s_barrier()
#define PG8_SCHED __builtin_amdgcn_sched_barrier(0)
    Unit cur, nxt; int ui = 0;
    if (!S.next(0, cur)) return;
    f32x4 acc[2][2][4][2];
    bf16x8 At[4][2], B0[2][2], B1[2][2];
    const char* cA = cur.A; const char* cB = cur.B;
    PG8_LAS v4u* gslot = (PG8_LAS v4u*)(lds + STAGE_BYTES) + tid;
    unsigned vA_c[2][2] = {{0u, 0u}, {0u, 0u}};
    if constexpr (GATHER) { PG8_GATHER_STORE(0, cur.rows); const v4u v0_ = gslot[0]; vA_c[0][0] = v0_.x; vA_c[0][1] = v0_.y; vA_c[1][0] = v0_.z; vA_c[1][1] = v0_.w; }
    PG8_STAGE(PG8_SB(0, 0), cB, voffB); PG8_STAGE(PG8_SB(0, 1), cB + hstepB, voffB); PG8_STAGE_A(PG8_SA(0, 0), cA, 0, vA_c); PG8_STAGE_A(PG8_SA(0, 1), cA, 1, vA_c);
    if (wr == 1) PG8_BAR;
    PG8_WAIT_V(2); PG8_BAR;
    PG8_STAGE(PG8_SB(1, 0), cB + kstep, voffB); PG8_STAGE_A(PG8_SA(1, 0), cA + kstep, 0, vA_c); PG8_STAGE(PG8_SB(1, 1), cB + hstepB + kstep, voffB);
    PG8_WAIT_V(6); PG8_BAR;
    float zf_ = 0.f; asm volatile("" : "+v"(zf_));
#pragma unroll
    for (int a = 0; a < 2; ++a)
#pragma unroll
        for (int b = 0; b < 2; ++b)
#pragma unroll
            for (int m = 0; m < 4; ++m)
#pragma unroll
                for (int n = 0; n < 2; ++n) acc[a][b][m][n] = (f32x4){zf_, zf_, zf_, zf_};
    for (;;) {
        const bool has_next = S.next(ui + 1, nxt);
        const char* nA = has_next ? nxt.A : cA; const char* nB = has_next ? nxt.B : cB;
        int gr_[2][2] = {{0, 0}, {0, 0}};
        if constexpr (GATHER) { const int* nrows_ = has_next ? nxt.rows : cur.rows;
#pragma unroll
            for (int hf_ = 0; hf_ < 2; ++hf_)
#pragma unroll
                for (int i_ = 0; i_ < 2; ++i_) { int R_, C_; stage_rc(tid * 16 + i_ * 8192, R_, C_); gr_[hf_][i_] = nrows_[hf_ * HALF + R_]; } }
        for (int t = 0; t < nt; t += 2) {
            const bool last = (t == nt - 2);
            unsigned vsel[2][2] = {{0u, 0u}, {0u, 0u}};
            if constexpr (GATHER) { const v4u vc_ = gslot[(ui & 1) * 512]; vA_c[1][0] = vc_.z; vA_c[1][1] = vc_.w;
                const v4u vn_ = gslot[((ui + (last ? 1 : 0)) & 1) * 512]; vsel[0][0] = vn_.x; vsel[0][1] = vn_.y; vsel[1][0] = vn_.z; vsel[1][1] = vn_.w; }
            const char* a1 = cA + (size_t)(t + 1) * kstep;
            const char* a2 = last ? nA : cA + (size_t)(t + 2) * kstep; const char* b2 = last ? nB : cB + (size_t)(t + 2) * kstep;
            const char* a3 = a2 + kstep; const char* b3 = b2 + kstep;
            PG8_LDB(B0, 0, 0); PG8_LDB(B1, 0, 1); PG8_SCHED; PG8_LDA(At, 0, 0); PG8_STAGE_A(PG8_SA(1, 1), a1, 1, vA_c);
            PG8_WAIT_V(8); PG8_WAIT_L(0); PG8_BAR; PG8_MMA(0, 0, At, B0); PG8_MMA(0, 1, At, B1); PG8_BAR; PG8_SCHED;
            PG8_LDA(At, 0, 1); PG8_STAGE(PG8_SB(0, 0), b2, voffB); PG8_STAGE(PG8_SB(0, 1), b2 + hstepB, voffB); PG8_STAGE_A(PG8_SA(0, 0), a2, 0, vsel);
            PG8_WAIT_V(8); PG8_WAIT_L(0); PG8_BAR; PG8_MMA(1, 0, At, B0); PG8_MMA(1, 1, At, B1); PG8_BAR; PG8_SCHED;
            PG8_LDB(B0, 1, 0); PG8_LDB(B1, 1, 1); PG8_SCHED; PG8_LDA(At, 1, 0); PG8_STAGE_A(PG8_SA(0, 1), a2, 1, vsel);
            PG8_WAIT_V(8); PG8_WAIT_L(0); PG8_BAR; PG8_MMA(0, 0, At, B0); PG8_MMA(0, 1, At, B1); PG8_BAR; PG8_SCHED;
            PG8_LDA(At, 1, 1); PG8_STAGE(PG8_SB(1, 0), b3, voffB); PG8_STAGE(PG8_SB(1, 1), b3 + hstepB, voffB); PG8_STAGE_A(PG8_SA(1, 0), a3, 0, vsel);
            PG8_WAIT_V(8); PG8_WAIT_L(0); PG8_BAR; PG8_MMA(1, 0, At, B0); PG8_MMA(1, 1, At, B1); PG8_BAR; PG8_SCHED;
            if constexpr (GATHER) { if (t == 0) { unsigned d_[2][2];
#pragma unroll
                for (int hf_ = 0; hf_ < 2; ++hf_)
#pragma unroll
                    for (int i_ = 0; i_ < 2; ++i_) { int R_, C_; stage_rc(tid * 16 + i_ * 8192, R_, C_); int tk_ = gr_[hf_][i_]; tk_ = tk_ < 0 ? 0 : tk_; d_[hf_][i_] = (unsigned)tk_ * (unsigned)(g.lda * 2) + (unsigned)(C_ * 2); }
                gslot[((ui + 1) & 1) * 512] = (v4u){d_[0][0], d_[0][1], d_[1][0], d_[1][1]}; } }
        }
        if constexpr (ALIGN_EPI) { if (wr == 0) PG8_BAR; }
        if constexpr (FP8) { asm volatile("s_nop 15\n\ts_nop 3"); }
        E(acc, cur, wr, wc, fr, fq);
        if (!has_next) break;
        if (!(Epi::KEEP && cur.aux == 0)) {
#pragma unroll
        for (int a = 0; a < 2; ++a)
#pragma unroll
            for (int b = 0; b < 2; ++b)
#pragma unroll
                for (int m = 0; m < 4; ++m)
#pragma unroll
                    for (int n = 0; n < 2; ++n) acc[a][b][m][n] = (f32x4){0.f, 0.f, 0.f, 0.f};
        }
        cur = nxt; cA = nA; cB = nB; ++ui;

        if constexpr (ALIGN_EPI) { if (wr == 1) PG8_BAR; }
    }
    PG8_WAIT_V(0);
    if constexpr (!ALIGN_EPI) { if (wr == 0) PG8_BAR; }
    PG8_BAR;
#undef PG8_SA
#undef PG8_SB
#undef PG8_STAGE
#undef PG8_STAGE_A
#undef PG8_GATHER_STORE
#undef PG8_LDA
#undef PG8_LDB
#undef PG8_MMA
#undef PG8_WAIT_V
#undef PG8_WAIT_L
#undef PG8_BAR
#undef PG8_SCHED
}

struct SchedPlain {
    const char* A; const char* Bt; int nM, nN, G, c; size_t astep, bstep;
    __device__ __forceinline__ bool next(int i, Unit& u) const {
        const long L = (long)i * G + c; if (L >= (long)nM * nN) return false;
        tile_of((int)L, nM, nN, u.pm, u.pn); u.aux = 0; u.rows = nullptr; u.A = A + (size_t)u.pm * astep; u.B = Bt + (size_t)u.pn * bstep; return true; }
};
struct SchedCols {
    const char* A; const char* Bt; int nM, nN, G, c; size_t astep, bstep; int pn0, gap_at, gap; bool bt_by_out;
    __device__ __forceinline__ bool next(int i, Unit& u) const {
        const long L = (long)i * G + c; if (L >= (long)nM * nN) return false;
        int pn_; tile_of((int)L, nM, nN, u.pm, pn_); u.pn = pn0 + pn_ + (pn_ >= gap_at ? gap : 0); u.aux = 0; u.rows = nullptr;
        u.A = A + (size_t)u.pm * astep; u.B = Bt + (size_t)(bt_by_out ? u.pn : pn_) * bstep; return true; }
};
struct SchedPair {
    const char* A; const char* Bt; int nM, nN, G, c; size_t astep, bstep, koff;
    __device__ __forceinline__ bool next(int i, Unit& u) const {
        const long L = (long)(i >> 1) * G + c; if (L >= (long)nM * nN) return false;
        tile_of((int)L, nM, nN, u.pm, u.pn); u.aux = i & 1; u.rows = nullptr; u.A = A + (size_t)u.pm * astep + (size_t)u.aux * koff; u.B = Bt + (size_t)u.pn * bstep + (size_t)u.aux * koff; return true; }
};
struct SchedMoe {
    const char* A; const char* Bt; const char* Bt2; int esplit; const PG8_LAS unsigned* tile_tab; const int* row_tab; int ntiles, nN, G, c; size_t astep, bstep_e, bstep_n;
    __device__ __forceinline__ bool next(int i, Unit& u) const {
        const int vc = (G % 8 == 0) ? (c % 8) * (G / 8) + c / 8 : c;
        const long L = (long)i * G + vc; if (L >= (long)ntiles * nN) return false;
        const int rt = (int)(L / nN), pn = (int)(L % nN); const int e = (int)tile_tab[rt];
        u.pm = rt; u.pn = pn; u.aux = e; u.rows = row_tab + rt * 256; u.A = A + (size_t)rt * astep; u.B = (e < esplit ? Bt + (size_t)e * bstep_e : Bt2 + (size_t)(e - esplit) * bstep_e) + (size_t)pn * bstep_n; return true; }
};

struct EpiProj {
    static constexpr bool PERM = true, KEEP = false;
    bf16 *Z, *XBC, *Q, *K, *V, *G; PG8_LAS float* nsc; unsigned *qmax, *kmax; float osc;
    __device__ __forceinline__ void operator()(f32x4 (&acc)[2][2][4][2], const Unit& u, int wr, int wc, int fr, int fq) const {
        const int row0 = u.pm * BM + wr * 64 + fr; const int pn = u.pn;
        if (pn >= 20 && pn < 36) {
#pragma unroll
            for (int ai = 0; ai < 2; ++ai)
#pragma unroll
                for (int m = 0; m < 4; ++m)
#pragma unroll
                    for (int bj = 0; bj < 2; ++bj) { const f32x4 v0 = acc[ai][bj][m][0], v1 = acc[ai][bj][m][1];
                        float s = ((v0[0] * v0[0] + v0[1] * v0[1]) + (v0[2] * v0[2] + v0[3] * v0[3])) + ((v1[0] * v1[0] + v1[1] * v1[1]) + (v1[2] * v1[2] + v1[3] * v1[3])); s *= osc * osc;
                        s += __shfl_xor(s, 16); s += __shfl_xor(s, 32);
                        if (fq == 0) nsc[((ai * HALF + wr * 64 + m * 16 + fr) * 2 + bj) * 4 + wc] = s; }
            asm volatile("s_waitcnt lgkmcnt(0)" ::: "memory"); __builtin_amdgcn_s_barrier();
            { const int t_ = threadIdx.x; const f32x4 p = *(const PG8_LAS f32x4*)(nsc + t_ * 4);
              float s = (p[0] + p[1]) + (p[2] + p[3]);
#pragma unroll
              for (int o = 2; o < 64; o <<= 1) s = fmaxf(s, __shfl_xor(s, o));
              if ((t_ & 63) < 2) { unsigned* dst = (pn < 28 ? qmax : kmax) + ((u.pm >> 4) * 16 + ((pn - 20) & 7) * 2 + (t_ & 1)) * 16 + (u.pm & 15);
                  __hip_atomic_fetch_max(dst, __float_as_uint(s * 1.008f), __ATOMIC_RELAXED, __HIP_MEMORY_SCOPE_AGENT); } }
        }
        bf16* base; int ldc, ct;
        if (pn < 8) { base = Z; ldc = 2048; ct = pn; }
        else if (pn < 20) { base = XBC; ldc = 3072; ct = pn - 8; }
        else if (pn < 28) { base = Q; ldc = 2048; ct = pn - 20; }
        else if (pn < 36) { base = K; ldc = 2048; ct = pn - 28; }
        else if (pn < 44) { base = V; ldc = 2048; ct = pn - 36; }
        else { base = G; ldc = 4096; ct = pn - 44; }
        const int col0 = ct * BM + wc * 32 + 8 * fq;
#pragma unroll
        for (int ai = 0; ai < 2; ++ai)
#pragma unroll
            for (int m = 0; m < 4; ++m) { bf16* rowp = base + (size_t)(row0 + ai * HALF + m * 16) * ldc + col0;
#pragma unroll
                for (int bj = 0; bj < 2; ++bj) { const f32x4 v0 = acc[ai][bj][m][0] * osc, v1 = acc[ai][bj][m][1] * osc;
                    v4u w; w.x = cvt_pk_bf16(v0[0], v0[1]); w.y = cvt_pk_bf16(v0[2], v0[3]); w.z = cvt_pk_bf16(v1[0], v1[1]); w.w = cvt_pk_bf16(v1[2], v1[3]);
                    *(v4u*)(rowp + bj * HALF) = w; } }
    }
};
struct EpiMix {
    static constexpr bool PERM = true, KEEP = true;
    const bf16* G; const float* SS; bf16* MIX; PG8_LAS float* RL;
    __device__ __forceinline__ void operator()(f32x4 (&acc)[2][2][4][2], const Unit& u, int wr, int wc, int fr, int fq) const {
        const int row0 = u.pm * BM + wr * 64 + fr, col0 = u.pn * BM + wc * 32 + 8 * fq;
        if (u.aux == 0) {
            const int t = threadIdx.x, r = t >> 1, hf = t & 1; const f32x4* sp = (const f32x4*)(SS + (size_t)(u.pm * BM + r) * 32 + hf * 16); float s = 0.f;
#pragma unroll
            for (int q = 0; q < 4; ++q) { const f32x4 x = sp[q]; s += (x[0] + x[1]) + (x[2] + x[3]); }
            s += __shfl_xor(s, 1);
            if (hf == 0) RL[r] = 1.0f / sqrtf(s * (1.f / 2048.f) + EPS);
            asm volatile("s_waitcnt lgkmcnt(0)" ::: "memory"); __builtin_amdgcn_s_barrier(); asm volatile("" ::: "memory");
        }
#pragma unroll
        for (int ai = 0; ai < 2; ++ai)
#pragma unroll
            for (int m = 0; m < 4; ++m) { const int row = row0 + ai * HALF + m * 16;
                float rs = 1.f;
                if (u.aux == 0) rs = RL[wr * 64 + fr + ai * HALF + m * 16];
#pragma unroll
                for (int bj = 0; bj < 2; ++bj) { const int col = col0 + bj * HALF;
                    const v4u gf = *(const v4u*)(G + (size_t)row * 4096 + 2048 + col);
                    const float ef[8] = {__expf(-bflo(gf.x)), __expf(-bfhi(gf.x)), __expf(-bflo(gf.y)), __expf(-bfhi(gf.y)), __expf(-bflo(gf.z)), __expf(-bfhi(gf.z)), __expf(-bflo(gf.w)), __expf(-bfhi(gf.w))};
                    if (u.aux == 0) {
                        const v4u gs = *(const v4u*)(G + (size_t)row * 4096 + col);
                        const float sg[8] = {sigmoidf_(bflo(gs.x)), sigmoidf_(bfhi(gs.x)), sigmoidf_(bflo(gs.y)), sigmoidf_(bfhi(gs.y)), sigmoidf_(bflo(gs.z)), sigmoidf_(bfhi(gs.z)), sigmoidf_(bflo(gs.w)), sigmoidf_(bfhi(gs.w))};
#pragma unroll
                        for (int e = 0; e < 8; ++e) acc[ai][bj][m][e >> 2][e & 3] *= sg[e] * rs * (1.f + ef[e]);
                    } else {
                        float v[8];
#pragma unroll
                        for (int e = 0; e < 8; ++e) v[e] = acc[ai][bj][m][e >> 2][e & 3] * __builtin_amdgcn_rcpf(1.f + ef[e]);
                        v4u w; w.x = cvt_pk_bf16(v[0], v[1]); w.y = cvt_pk_bf16(v[2], v[3]); w.z = cvt_pk_bf16(v[4], v[5]); w.w = cvt_pk_bf16(v[6], v[7]);
                        *(v4u*)(MIX + (size_t)row * 2048 + col) = w; } } }
    }
};
struct EpiMixA {
    static constexpr bool PERM = true, KEEP = false;
    const bf16* G; const float* SS; bf16* P; PG8_LAS float* RL;
    __device__ __forceinline__ void operator()(f32x4 (&acc)[2][2][4][2], const Unit& u, int wr, int wc, int fr, int fq) const {
        const int row0 = u.pm * BM + wr * 64 + fr, col0 = u.pn * BM + wc * 32 + 8 * fq;
        { const int t = threadIdx.x, r = t >> 1, hf = t & 1; const f32x4* sp = (const f32x4*)(SS + (size_t)(u.pm * BM + r) * 32 + hf * 16); float s = 0.f;
#pragma unroll
          for (int q = 0; q < 4; ++q) { const f32x4 x = sp[q]; s += (x[0] + x[1]) + (x[2] + x[3]); }
          s += __shfl_xor(s, 1);
          asm volatile("s_waitcnt lgkmcnt(0)" ::: "memory"); __builtin_amdgcn_s_barrier();
          if (hf == 0) RL[r] = 1.0f / sqrtf(s * (1.f / 2048.f) + EPS);
          asm volatile("s_waitcnt lgkmcnt(0)" ::: "memory"); __builtin_amdgcn_s_barrier(); asm volatile("" ::: "memory"); }
#pragma unroll
        for (int ai = 0; ai < 2; ++ai)
#pragma unroll
            for (int m = 0; m < 4; ++m) { const int row = row0 + ai * HALF + m * 16; const float rs = RL[wr * 64 + fr + ai * HALF + m * 16];
#pragma unroll
                for (int bj = 0; bj < 2; ++bj) { const int col = col0 + bj * HALF;
                    const v4u gs = __builtin_nontemporal_load((const v4u*)(G + (size_t)row * 4096 + col));
                    const float sg[8] = {sigmoidf_(bflo(gs.x)), sigmoidf_(bfhi(gs.x)), sigmoidf_(bflo(gs.y)), sigmoidf_(bfhi(gs.y)), sigmoidf_(bflo(gs.z)), sigmoidf_(bfhi(gs.z)), sigmoidf_(bflo(gs.w)), sigmoidf_(bfhi(gs.w))};
                    float v[8];
#pragma unroll
                    for (int e = 0; e < 8; ++e) v[e] = acc[ai][bj][m][e >> 2][e & 3] * (sg[e] * rs);
                    v4u w; w.x = cvt_pk_bf16(v[0], v[1]); w.y = cvt_pk_bf16(v[2], v[3]); w.z = cvt_pk_bf16(v[4], v[5]); w.w = cvt_pk_bf16(v[6], v[7]);
                    *(v4u*)(P + (size_t)row * 2048 + col) = w; } }
    }
};
struct EpiMixB {
    static constexpr bool PERM = true, KEEP = false;
    const bf16* G; const bf16* P; bf16* MIX; float sc;
    __device__ __forceinline__ void operator()(f32x4 (&acc)[2][2][4][2], const Unit& u, int wr, int wc, int fr, int fq) const {
        const int row0 = u.pm * BM + wr * 64 + fr, col0 = u.pn * BM + wc * 32 + 8 * fq;
#pragma unroll
        for (int ai = 0; ai < 2; ++ai)
#pragma unroll
            for (int m = 0; m < 4; ++m) { const int row = row0 + ai * HALF + m * 16;
#pragma unroll
                for (int bj = 0; bj < 2; ++bj) { const int col = col0 + bj * HALF;
                    const v4u gf = __builtin_nontemporal_load((const v4u*)(G + (size_t)row * 4096 + 2048 + col));
                    const v4u pp = *(const v4u*)(P + (size_t)row * 2048 + col);
                    const float sg[8] = {sigmoidf_(bflo(gf.x)), sigmoidf_(bfhi(gf.x)), sigmoidf_(bflo(gf.y)), sigmoidf_(bfhi(gf.y)), sigmoidf_(bflo(gf.z)), sigmoidf_(bfhi(gf.z)), sigmoidf_(bflo(gf.w)), sigmoidf_(bfhi(gf.w))};
                    const float pv[8] = {bflo(pp.x), bfhi(pp.x), bflo(pp.y), bfhi(pp.y), bflo(pp.z), bfhi(pp.z), bflo(pp.w), bfhi(pp.w)};
                    float v[8];
#pragma unroll
                    for (int e = 0; e < 8; ++e) v[e] = pv[e] + acc[ai][bj][m][e >> 2][e & 3] * (sc * sg[e]);
                    v4u w; w.x = cvt_pk_bf16(v[0], v[1]); w.y = cvt_pk_bf16(v[2], v[3]); w.z = cvt_pk_bf16(v[4], v[5]); w.w = cvt_pk_bf16(v[6], v[7]);
                    *(v4u*)(MIX + (size_t)row * 2048 + col) = w; } }
    }
};
struct EpiRes {
    static constexpr bool PERM = true, KEEP = false;
    const float* X; bf16* H;
    __device__ __forceinline__ void operator()(f32x4 (&acc)[2][2][4][2], const Unit& u, int wr, int wc, int fr, int fq) const {
        const int row0 = u.pm * BM + wr * 64 + fr, col0 = u.pn * BM + wc * 32 + 8 * fq;
#pragma unroll
        for (int ai = 0; ai < 2; ++ai)
#pragma unroll
            for (int m = 0; m < 4; ++m) { const size_t off = (size_t)(row0 + ai * HALF + m * 16) * 2048 + col0;
#pragma unroll
                for (int bj = 0; bj < 2; ++bj) { const f32x4 x0 = __builtin_nontemporal_load((const f32x4*)(X + off + bj * HALF)), x1 = __builtin_nontemporal_load((const f32x4*)(X + off + bj * HALF + 4));
                    const f32x4 v0 = x0 + acc[ai][bj][m][0], v1 = x1 + acc[ai][bj][m][1];
                    v4u w; w.x = cvt_pk_bf16(v0[0], v0[1]); w.y = cvt_pk_bf16(v0[2], v0[3]); w.z = cvt_pk_bf16(v1[0], v1[1]); w.w = cvt_pk_bf16(v1[2], v1[3]);
                    *(v4u*)(H + off + bj * HALF) = w; } }
    }
};
struct EpiGU {
    static constexpr bool PERM = true, KEEP = false;
    bf16* HDN; float wsc;
    __device__ __forceinline__ void operator()(f32x4 (&acc)[2][2][4][2], const Unit& u, int wr, int wc, int fr, int fq) const {
        const int row0 = u.pm * BM + wr * 64 + fr, col0 = u.pn * HALF + wc * 32 + 8 * fq;
#pragma unroll
        for (int ai = 0; ai < 2; ++ai)
#pragma unroll
            for (int m = 0; m < 4; ++m) { float v[8];
#pragma unroll
                for (int e = 0; e < 8; ++e) { const float gt = acc[ai][0][m][e >> 2][e & 3] * wsc, up = acc[ai][1][m][e >> 2][e & 3] * wsc; v[e] = siluf_(gt) * up; }
                v2u w; w.x = cvt_fp8x4(v[0], v[1], v[2], v[3]); w.y = cvt_fp8x4(v[4], v[5], v[6], v[7]);
                *(v2u*)((unsigned char*)HDN + (size_t)(row0 + ai * HALF + m * 16) * 512 + col0) = w; }
    }
};
struct EpiPlain {
    static constexpr bool PERM = true, KEEP = false;
    unsigned char* O; int ldc; float sc;
    __device__ __forceinline__ void operator()(f32x4 (&acc)[2][2][4][2], const Unit& u, int wr, int wc, int fr, int fq) const {
        const int row0 = u.pm * BM + wr * 64 + fr, col0 = u.pn * BM + wc * 32 + 8 * fq;
#pragma unroll
        for (int ai = 0; ai < 2; ++ai)
#pragma unroll
            for (int m = 0; m < 4; ++m) { unsigned char* rowp = O + (size_t)(row0 + ai * HALF + m * 16) * ldc + col0;
#pragma unroll
                for (int bj = 0; bj < 2; ++bj) { const f32x4 v0 = acc[ai][bj][m][0] * sc, v1 = acc[ai][bj][m][1] * sc;
                    v2u w; w.x = cvt_fp8x4(v0[0], v0[1], v0[2], v0[3]); w.y = cvt_fp8x4(v1[0], v1[1], v1[2], v1[3]);
                    *(v2u*)(rowp + bj * HALF) = w; } }
    }
};
}

namespace att {
constexpr int D = 128, KP = 2048, OP = 4096;
constexpr float SCALE = 0.08838834764831845f;
constexpr int NW = 8, QBLK = 32, KVBLK = 64, QB = NW * QBLK;
constexpr int SHM_V = KVBLK * D * 2, SHM_K = KVBLK * D * 2;
constexpr int LDS_WS = 2 * SHM_V + 2 * SHM_K, LDS_BIAS = LDS_WS + NW * 64 * 4, LDS_BYTES = LDS_BIAS + SEQ * 16;
constexpr float THR = 8.f;
constexpr unsigned WBIG = 0x40000000u;
#define KSWZ(row, colB) ((row) * 256 + ((colB) ^ (((row) & 7) << 4)))
#define SBAR() __builtin_amdgcn_sched_barrier(0)
__device__ __forceinline__ int v_st(int k, int c) { const int kk = (k & ~0xC) | ((k & 4) << 1) | ((k & 8) >> 1); return ((kk >> 3) * 4 + (c >> 5)) * 512 + ((kk & 7) * 32 + (c & 31)) * 2; }
__device__ __forceinline__ int v_rd_base(int lane) { return ((lane & 3) << 3) | (((lane >> 2) & 3) << 6) | (((lane >> 4) & 1) << 5) | (((lane >> 5) & 1) << 8); }
constexpr int v_rd_off(int d0, int ks, int half) { return d0 * 512 + ks * 4096 + half * 2048; }
__device__ __forceinline__ int crow(int r, int hi) { return (r & 3) + 8 * (r >> 2) + 4 * hi; }
__device__ __forceinline__ unsigned cvtpk(float lo, float hi) { unsigned r; asm volatile("v_cvt_pk_bf16_f32 %0, %1, %2" : "=v"(r) : "v"(lo), "v"(hi)); return r; }
__device__ __forceinline__ bf16x8 load8(const bf16* p) { return *reinterpret_cast<const bf16x8*>(p); }
__device__ __forceinline__ void mask_tile(f32x16& p0, f32x16& p1, int dq, unsigned W) {
    const float NEG = -__builtin_inff();
#pragma unroll
    for (int r = 0; r < 16; ++r) {
        const int c = (r & 3) + 8 * (r >> 2);
        if ((unsigned)(dq - c) >= W) p0[r] = NEG;
        if ((unsigned)(dq - c - 32) >= W) p1[r] = NEG;
    }
}
__device__ __forceinline__ void partialSM(f32x16& p0, f32x16& p1, float& m_reg, float& mn, float& alpha) {
    float pmax = p0[0]; for (int r = 1; r < 16; ++r) pmax = fmaxf(pmax, p0[r]); for (int r = 0; r < 16; ++r) pmax = fmaxf(pmax, p1[r]);
    { auto rr = __builtin_amdgcn_permlane32_swap(__float_as_uint(pmax), __float_as_uint(pmax), false, false);
      pmax = fmaxf(__uint_as_float(rr[0]), __uint_as_float(rr[1])); }
    constexpr float C2 = 1.4426950408889634f * SCALE;
    if (__builtin_expect(__all((pmax - m_reg) * SCALE <= THR), 1)) { mn = m_reg; alpha = 1.f; }
    else { mn = fmaxf(m_reg, pmax); alpha = __builtin_amdgcn_exp2f((m_reg - mn) * C2); m_reg = mn; }
    const float mnL = -mn * C2;
    for (int r = 0; r < 16; ++r) p0[r] = fmaf(p0[r], C2, mnL); for (int r = 0; r < 16; ++r) p1[r] = fmaf(p1[r], C2, mnL);
    for (int r = 0; r < 16; ++r) p0[r] = __builtin_amdgcn_exp2f(p0[r]);
}
__device__ __forceinline__ void finishSM(f32x16& p0, f32x16& p1, float alpha, float& l_reg, bf16x8& pa0, bf16x8& pa1, bf16x8& pa2, bf16x8& pa3) {
    for (int r = 0; r < 16; ++r) p1[r] = __builtin_amdgcn_exp2f(p1[r]);
    float ps = 0; for (int r = 0; r < 16; ++r) ps += p0[r]; for (int r = 0; r < 16; ++r) ps += p1[r];
    { auto rr = __builtin_amdgcn_permlane32_swap(__float_as_uint(ps), __float_as_uint(ps), false, false);
      ps = __uint_as_float(rr[0]) + __uint_as_float(rr[1]); }
    l_reg = l_reg * alpha + ps;
#define PK4(P, B_, OUT) do { unsigned a0 = cvtpk(P[B_+0], P[B_+1]), a1 = cvtpk(P[B_+2], P[B_+3]);                          \
        unsigned b0 = cvtpk(P[B_+4], P[B_+5]), b1 = cvtpk(P[B_+6], P[B_+7]);                                             \
        auto r0 = __builtin_amdgcn_permlane32_swap(a0, b0, false, false); auto r1 = __builtin_amdgcn_permlane32_swap(a1, b1, false, false); \
        v4u w = {r0[0], r1[0], r0[1], r1[1]}; OUT = *reinterpret_cast<bf16x8*>(&w); } while (0)
    PK4(p0, 0, pa0); PK4(p0, 8, pa1); PK4(p1, 0, pa2); PK4(p1, 8, pa3);
#undef PK4
}
template <int KB>
__device__ __forceinline__ void qkt(f32x16& p0, f32x16& p1, const char* K_lds, int r32, int hi, const bf16x8* qr, const char* bt, const bf16x8 qones, const bool nobias = false) {
    if (nobias) {
#pragma unroll
        for (int r = 0; r < 16; ++r) { p0[r] = 0.f; p1[r] = 0.f; } }
    else { const v2u f0 = *(const v2u*)bt, f1 = *(const v2u*)(bt + 32 * 16);
        const v4u w0 = {f0.x, f0.y, 0u, 0u}, w1 = {f1.x, f1.y, 0u, 0u};
        const f32x16 z = {};
        p0 = __builtin_amdgcn_mfma_f32_32x32x16_bf16(__builtin_bit_cast(bf16x8, w0), qones, z, 0, 0, 0);
        p1 = __builtin_amdgcn_mfma_f32_32x32x16_bf16(__builtin_bit_cast(bf16x8, w1), qones, z, 0, 0, 0); }
    const char* kb[4];
#pragma unroll
    for (int dd = 0; dd < 4; ++dd) kb[dd] = K_lds + KB * SHM_K + KSWZ(r32, (dd * 16 + hi * 8) * 2);
#pragma unroll
    for (int d0 = 0; d0 < 8; ++d0) { const char* a = kb[d0 & 3] + (d0 >> 2) * 128;
        bf16x8 b0 = *reinterpret_cast<const bf16x8*>(a);
        bf16x8 b1 = *reinterpret_cast<const bf16x8*>(a + 32 * 256);
        p0 = __builtin_amdgcn_mfma_f32_32x32x16_bf16(b0, qr[d0], p0, 0, 0, 0);
        p1 = __builtin_amdgcn_mfma_f32_32x32x16_bf16(b1, qr[d0], p1, 0, 0, 0); }
}
template <int VB>
__device__ __forceinline__ void pv_tile(f32x16* o, int vb0, bf16x8 pa0, bf16x8 pa1, bf16x8 pa2, bf16x8 pa3) {
#define TRRD(dst, off) asm volatile("ds_read_b64_tr_b16 %0, %1 offset:%2" : "=&v"(dst) : "v"(vb0), "i"(off) : "memory")
#define PV_D0(d0) do { s16x4 l0, l1, l2, l3, h0, h1, h2, h3; constexpr int b_ = VB * SHM_V + v_rd_off(d0, 0, 0); \
        TRRD(l0, b_); TRRD(h0, b_ + 2048); TRRD(l1, b_ + 4096); TRRD(h1, b_ + 6144); TRRD(l2, b_ + 8192); TRRD(h2, b_ + 10240); TRRD(l3, b_ + 12288); TRRD(h3, b_ + 14336); \
        asm volatile("s_waitcnt lgkmcnt(0)" ::: "memory"); SBAR();   \
        o[d0] = __builtin_amdgcn_mfma_f32_32x32x16_bf16(pa0, (bf16x8){l0[0], l0[1], l0[2], l0[3], h0[0], h0[1], h0[2], h0[3]}, o[d0], 0, 0, 0);   \
        o[d0] = __builtin_amdgcn_mfma_f32_32x32x16_bf16(pa1, (bf16x8){l1[0], l1[1], l1[2], l1[3], h1[0], h1[1], h1[2], h1[3]}, o[d0], 0, 0, 0);   \
        o[d0] = __builtin_amdgcn_mfma_f32_32x32x16_bf16(pa2, (bf16x8){l2[0], l2[1], l2[2], l2[3], h2[0], h2[1], h2[2], h2[3]}, o[d0], 0, 0, 0);   \
        o[d0] = __builtin_amdgcn_mfma_f32_32x32x16_bf16(pa3, (bf16x8){l3[0], l3[1], l3[2], l3[3], h3[0], h3[1], h3[2], h3[3]}, o[d0], 0, 0, 0); } while (0)
    PV_D0(0); PV_D0(1); PV_D0(2); PV_D0(3);
#undef PV_D0
#undef TRRD
}
struct BlockRef { const bf16* Q; const bf16* K; const bf16* V; unsigned char* O; const float* C; int P0, jlo; };
struct Seam { bf16x8 qr[8]; bf16x8 st_v0, st_v1, st_k0, st_k1; };
#define VMW() asm volatile("s_waitcnt vmcnt(0)" ::: "memory")
#define VMWN(n) asm volatile("s_waitcnt vmcnt(%0)" :: "i"(n) : "memory")
#define SLOAD_H(Kp, Vp, k0) do { const char* kb_ = (const char*)(Kp) + (size_t)(k0) * (KP * 2); const char* vb_ = (const char*)(Vp) + (size_t)(k0) * (KP * 2);   \
                         S.st_v0 = *(const bf16x8*)(vb_ + ldoff); S.st_v1 = *(const bf16x8*)(vb_ + 32 * KP * 2 + ldoff);              \
                         S.st_k0 = *(const bf16x8*)(kb_ + ldoff); S.st_k1 = *(const bf16x8*)(kb_ + 32 * KP * 2 + ldoff); } while (0)
#define SWRITE_HK(bf) do { *(bf16x8*)(K_lds + (bf) * SHM_K + kws) = S.st_k0; *(bf16x8*)(K_lds + (bf) * SHM_K + kws + 32 * 256) = S.st_k1; } while (0)
#define SWRITE_HV(bf) do { *(bf16x8*)(V_lds + (bf) * SHM_V + vst0) = S.st_v0; *(bf16x8*)(V_lds + (bf) * SHM_V + vst1) = S.st_v1; } while (0)
#define SWRITE_H(bf) do { SWRITE_HV(bf); SWRITE_HK(bf); } while (0)
__device__ __forceinline__ void attn_prime(const BlockRef& cur, char* lds, Seam& S) {
    const int tid = threadIdx.x, wid = __builtin_amdgcn_readfirstlane(tid >> 6), lane = tid & 63, r32 = lane & 31, hi = lane >> 5;
    const int sr = tid >> 4, sc = (tid & 15) * 8, kws = KSWZ(sr, sc * 2); char* K_lds = lds + 2 * SHM_V;
    const unsigned ldoff = (unsigned)(sr * KP + sc) * 2u, qoff = (unsigned)(r32 * KP + hi * 8) * 2u;
    { const char* qb_ = (const char*)cur.Q + (size_t)(wid * QBLK) * (KP * 2);
      for (int d0 = 0; d0 < 8; ++d0) S.qr[d0] = *(const bf16x8*)(qb_ + qoff + d0 * 32); }
    SLOAD_H(cur.K, cur.V, cur.P0 + QB - KVBLK); VMW(); SWRITE_HK(0);
    __syncthreads();
}
__device__ __forceinline__ void attn_fetch_w0(unsigned* qctr, const unsigned* qm, const unsigned* km, const float* CUM, int q0, int* slot);
struct Fetch { unsigned* qctr; const unsigned* qm; const unsigned* km; const float* CUM; int q0; int* slot; bool on; };
__device__ __forceinline__ void attn_block(const BlockRef& cur, const BlockRef& nxt, char* lds, Seam& S, const int pflags, const Fetch& F) {
    const int tid = threadIdx.x, wid = __builtin_amdgcn_readfirstlane(tid >> 6), lane = tid & 63, r32 = lane & 31, hi = lane >> 5;
    const int NT = (cur.P0 + QB - 1) / KVBLK + 1 - cur.jlo;
    const int qlo = cur.P0 + wid * QBLK, qm = qlo + r32 - 4 * hi;
    char* V_lds = lds; char* K_lds = lds + 2 * SHM_V;
    float* ws = (float*)(lds + LDS_WS) + wid * 64; float* li_l = ws, * al_l = ws + 32;
    char* biasT = lds + LDS_BIAS;
    if (wid == 0 && F.on) attn_fetch_w0(F.qctr, F.qm, F.km, F.CUM, F.q0, F.slot);
    else { const int nkeys = cur.P0 + QB; const float cref = cur.C[cur.P0];
      const unsigned jstep = F.on ? 7168u : 8192u;
      unsigned jo = (unsigned)(F.on ? tid - 64 : tid) * 16u; asm volatile("" : "+v"(jo));
      for (; jo < (unsigned)nkeys * 4u; jo += jstep) { const f32x4 c = *(const f32x4*)((const char*)cur.C + jo); const f32x4 bv = (cref - c) * (1.0f / SCALE);
#pragma unroll
          for (int e = 0; e < 4; ++e) { const float b0 = bv[e]; const unsigned h = f2bf(b0); const float r1 = b0 - bf2f(h); const unsigned m = f2bf(r1); const unsigned l = f2bf(r1 - bf2f(m));
              *(v4u*)(biasT + (size_t)jo * 4 + e * 16) = (v4u){h | (m << 16), l, 0u, 0u}; } } }
    __syncthreads();
    const char* bt0 = biasT + r32 * 16 + hi * 8;
    const v4u qow = {hi ? 0u : 0x3F803F80u, hi ? 0u : 0x00003F80u, 0u, 0u}; const bf16x8 qones = __builtin_bit_cast(bf16x8, qow);
    float m_reg = -1e30f, l_reg = 0; f32x16 o[4] = {};
    const int sr = tid >> 4, sc = (tid & 15) * 8, vst0 = v_st(sr, sc), vst1 = v_st(32 + sr, sc), kws = KSWZ(sr, sc * 2);
    const unsigned ldoff = (unsigned)(sr * KP + sc) * 2u;
    const int vb0 = (int)(uintptr_t)V_lds + v_rd_base(lane);
    const bf16* Kh = cur.K; const bf16* Vh = cur.V;
#define RESC(a) do { if (__any((a) < 1.f)) { if (hi == 0) al_l[r32] = (a); asm volatile("s_waitcnt lgkmcnt(0)" ::: "memory");              \
                     for (int d_ = 0; d_ < 4; ++d_) for (int r = 0; r < 16; ++r) o[d_][r] *= al_l[crow(r, hi)]; } } while (0)
#define KBASE(t) ((cur.jlo + NT - 1 - (t)) * KVBLK)
#define MASKT(P0_, P1_, t) do { const int kb_ = KBASE(t); if (kb_ + KVBLK - 1 > qlo) mask_tile(P0_, P1_, qm - kb_, WBIG); } while (0)
#define SEAM_K0() do { VMWN(8); SWRITE_HK(0); SBAR(); } while (0)
    f32x16 pA0, pA1, pB0, pB1; float mnA, mnB, alA, alB; bf16x8 pa0, pa1, pa2, pa3;
    if (wid >= 4) __builtin_amdgcn_s_setprio(1);
    SWRITE_HV(0); SBAR();
    if (NT > 1) { SLOAD_H(Kh, Vh, KBASE(1)); }
    SBAR(); qkt<0>(pA0, pA1, K_lds, r32, hi, S.qr, bt0 + KBASE(0) * 16, qones, (pflags & 2) != 0);
    MASKT(pA0, pA1, 0); partialSM(pA0, pA1, m_reg, mnA, alA);
    if (NT > 1) { VMW(); SWRITE_H(1); }
    __syncthreads();
#define HALF_STEP(PX0, PX1, mnX, alX, PY0, PY1, alY, t, KB, VB, SB) do {                                                      \
        SBAR(); qkt<KB>(PX0, PX1, K_lds, r32, hi, S.qr, bt0 + KBASE(t) * 16, qones, (pflags & 2) != 0);                                                      \
        finishSM(PY0, PY1, alY, l_reg, pa0, pa1, pa2, pa3); SBAR();                                                           \
        if ((t) + 1 < NT) { SLOAD_H(Kh, Vh, KBASE((t) + 1)); SBAR(); }                                                        \
        pv_tile<VB>(o, vb0, pa0, pa1, pa2, pa3); MASKT(PX0, PX1, (t)); partialSM(PX0, PX1, m_reg, mnX, alX);                  \
        __syncthreads();                                                                                                      \
        if ((t) + 1 < NT) { VMW(); SWRITE_H(SB); }                                                                            \
        RESC(alX); __syncthreads(); } while (0)
    for (int t = 1; t + 1 < NT; t += 2) {
        HALF_STEP(pB0, pB1, mnB, alB, pA0, pA1, alA, t, 1, 0, 0);
        HALF_STEP(pA0, pA1, mnA, alA, pB0, pB1, alB, t + 1, 0, 1, 1);
    }
    const bool even = (NT & 1) == 0;
    if (even) { SBAR(); qkt<1>(pB0, pB1, K_lds, r32, hi, S.qr, bt0 + KBASE(NT - 1) * 16, qones, (pflags & 2) != 0); SBAR(); }
    SLOAD_H(nxt.K, nxt.V, nxt.P0 + QB - KVBLK); SBAR();
    { const unsigned qoff = (unsigned)(r32 * KP + hi * 8) * 2u; const char* qb_ = (const char*)nxt.Q + (size_t)(wid * QBLK) * (KP * 2);
#pragma unroll
      for (int d0 = 0; d0 < 8; ++d0) S.qr[d0] = *(const bf16x8*)(qb_ + qoff + d0 * 32); }
    SBAR();
    finishSM(pA0, pA1, alA, l_reg, pa0, pa1, pa2, pa3); SBAR();
    pv_tile<0>(o, vb0, pa0, pa1, pa2, pa3);
    if (even) { MASKT(pB0, pB1, NT - 1); partialSM(pB0, pB1, m_reg, mnB, alB); __syncthreads(); RESC(alB);
        finishSM(pB0, pB1, alB, l_reg, pa0, pa1, pa2, pa3); SBAR(); pv_tile<1>(o, vb0, pa0, pa1, pa2, pa3); }
    SBAR(); SEAM_K0();
    if (hi == 0) li_l[r32] = l_reg; asm volatile("s_waitcnt lgkmcnt(0)" ::: "memory");
    float rli[16];
#pragma unroll
    for (int r = 0; r < 16; ++r) rli[r] = __builtin_amdgcn_rcpf(li_l[crow(r, hi)]) * YF_SCALE;
    char* Ob = (char*)cur.O + (size_t)(wid * QBLK) * 2048; const unsigned ooff = (unsigned)(4 * hi * 2048 + r32);
#pragma unroll
    for (int r = 0; r < 16; ++r) {
#pragma unroll
        for (int d0 = 0; d0 < 4; ++d0) { const float v = o[d0][r] * rli[r];
            const float vn = __shfl_xor(v, 1);
            if ((r32 & 1) == 0 && !(pflags & 1)) *(unsigned short*)(Ob + (size_t)(((r & 3) + 8 * (r >> 2)) * 2048 + d0 * 32) + ooff) = (unsigned short)cvt_fp8x2(v, vn, 0u, false); } }
    __builtin_amdgcn_s_setprio(0);
    __syncthreads();
#undef RESC
#undef KBASE
#undef MASKT
#undef SEAM_K0
#undef HALF_STEP
}
#undef VMW
#undef VMWN
#undef SLOAD_H
#undef SWRITE_HK
#undef SWRITE_HV
#undef SWRITE_H
__device__ __forceinline__ BlockRef blk_ref(int code, int jlo, const bf16* Q, const bf16* K, const bf16* V, unsigned char* AB, const float* CUM) {
    const int q = code >> 7, i = code & 127, qb = 15 - (i >> 3), bh = q + 8 * (i & 7), b = bh >> 4, h = bh & 15;
    BlockRef r; const size_t row0 = (size_t)b * SEQ;
    r.Q = Q + (row0 + (size_t)qb * QB) * KP + h * D; r.K = K + row0 * KP + h * D; r.V = V + row0 * KP + h * D;
    r.O = AB + (row0 + (size_t)qb * QB) * 2048 + h * D;        r.C = CUM + (size_t)bh * SEQ; r.P0 = qb * QB; r.jlo = jlo;
    return r;
}
__device__ __forceinline__ void attn_fetch_w0(unsigned* qctr, const unsigned* qm, const unsigned* km, const float* CUM, int q0, int* slot) {
    const int lane = threadIdx.x & 63; int res = -1;
    if (lane == 0) { for (int a = 0; a < 8; ++a) { const int q = (q0 + a) & 7; const unsigned t = __hip_atomic_fetch_add(qctr + 64 * q, 1u, __ATOMIC_RELAXED, __HIP_MEMORY_SCOPE_AGENT); if (t < 128u) { res = q * 128 + (int)t; break; } } }
    res = __builtin_amdgcn_readfirstlane(res);
    int jl = 0;
    if (res >= 0) { const int q = res >> 7, i = res & 127, qb = 15 - (i >> 3), bh = q + 8 * (i & 7), P0 = qb * QB;
        const float qn2 = __uint_as_float(__hip_atomic_load(qm + bh * 16 + qb, __ATOMIC_RELAXED, __HIP_MEMORY_SCOPE_AGENT));
        unsigned lo4 = (unsigned)(lane & 15) * 4u, lo256 = (unsigned)lane * 256u + 252u; asm volatile("" : "+v"(lo4), "+v"(lo256));
        float kn2 = (lane <= qb) ? __uint_as_float(__hip_atomic_load((const unsigned*)((const char*)(km + bh * 16) + lo4), __ATOMIC_RELAXED, __HIP_MEMORY_SCOPE_AGENT)) : 0.f;
#pragma unroll
        for (int o = 1; o < 16; o <<= 1) kn2 = fmaxf(kn2, __shfl_xor(kn2, o));
        kn2 = __shfl(kn2, 0);
        const float slack = 2.0f * sqrtf(qn2 * kn2) * SCALE * 1.001f + THR;
        const float* cu = CUM + (size_t)bh * SEQ; const float cref = cu[P0];
        const float cend = (lane < (P0 >> 6)) ? *(const float*)((const char*)cu + lo256) : cref;
        const bool skip = (lane < (P0 >> 6)) && ((cref - cend) + slack < -125.0f);
        const unsigned long long m = __ballot(skip);
        jl = (int)__builtin_ctzll(~m);
    }
    if (lane == 0) { slot[0] = res; slot[1] = jl; }
}
__device__ __forceinline__ int attn_pull(unsigned* qctr, const unsigned* qm, const unsigned* km, const float* CUM, int q0, int* slot, int& jlo) {
    if (threadIdx.x < 64) attn_fetch_w0(qctr, qm, km, CUM, q0, slot);
    __syncthreads();
    const int r = slot[0]; jlo = slot[1];
    __syncthreads();
    return r;
}
__device__ __forceinline__ void attn_phase(char* lds, const bf16* Q, const bf16* K, const bf16* V, unsigned char* AB, const float* CUM, unsigned* qctr, const unsigned* qm, const unsigned* km, int q0, const int pflags) {
    int* slot = (int*)(lds + LDS_BYTES);
    int jc = 0, jn = 0;
    int tc = attn_pull(qctr, qm, km, CUM, q0, slot, jc); if (tc < 0) return;
    BlockRef cur = blk_ref(tc, jc, Q, K, V, AB, CUM);
    Seam S;
    attn_prime(cur, lds, S);
    int tn = attn_pull(qctr, qm, km, CUM, q0, slot, jn);
    for (int par = 0;; par ^= 1) {
        const bool last = tn < 0;
        const BlockRef nxt = last ? cur : blk_ref(tn, jn, Q, K, V, AB, CUM);
        const Fetch F{qctr, qm, km, CUM, q0, slot + 2 * par, !last};
        attn_block(cur, nxt, lds, S, pflags, F);
        if (last) break;
        cur = nxt; tn = slot[2 * par]; jn = slot[2 * par + 1];
    }
}
}

#define XB_TMO      128
#define XB_XCNT(j)  (256  + 64 * (j))
#define XB_XSUB(j)  (1280 + 64 * (j))
#define XB_XGEN(j)  (2304 + 64 * (j))
#define XB_TOP      3328
#define XB_TOPGEN   3392
#define XCD_BAR_WORDS 3456
#define XB_SPIN_CAP (1u << 18)
__device__ __forceinline__ unsigned xb_ld(unsigned* p)              { return __hip_atomic_load(p, __ATOMIC_RELAXED, __HIP_MEMORY_SCOPE_AGENT); }
__device__ __forceinline__ unsigned xb_add(unsigned* p, unsigned v) { return __hip_atomic_fetch_add(p, v, __ATOMIC_RELAXED, __HIP_MEMORY_SCOPE_AGENT); }
__device__ __forceinline__ unsigned xb_xcc_id() { return (unsigned)__builtin_amdgcn_s_getreg((3 << 11) | 20) & 0xFu; }
#define XB_SPIN(cond, bar) do { unsigned _sp = 0; while (cond) { __builtin_amdgcn_s_sleep(1); \
    if ((++_sp & 255u) == 0u) { if (xb_ld(&(bar)[XB_TMO])) break; if (_sp > XB_SPIN_CAP) { atomicAdd(&(bar)[XB_TMO], 1u); break; } } } } while (0)
struct XcdBarrier { unsigned* bar; unsigned x; volatile LAS unsigned* st; };
__device__ __forceinline__ XcdBarrier xcd_barrier_post(unsigned* bar, volatile LAS unsigned* st) {
    XcdBarrier b; b.bar = bar; b.x = xb_xcc_id(); b.st = st;
    if (threadIdx.x == 0) (void)xb_add(&bar[XB_XCNT(b.x)], 1u);
    return b;
}
__device__ __forceinline__ void xcd_barrier_complete(unsigned* bar, unsigned x, unsigned& nloc, unsigned& nx) {
    const unsigned G = gridDim.x * gridDim.y * gridDim.z;
    unsigned sum, cnt, mine, sp = 0u;
    for (;;) {
        sum = 0u; cnt = 0u; mine = 0u;
#pragma unroll
        for (unsigned j = 0; j < 16; ++j) { const unsigned c = xb_ld(&bar[XB_XCNT(j)]); sum += c; cnt += (c > 0u) ? 1u : 0u; mine = (j == x) ? c : mine; }
        if (sum == G) break;
        __builtin_amdgcn_s_sleep(1);
        if ((++sp & 255u) == 0u) { if (xb_ld(&bar[XB_TMO])) break; if (sp > XB_SPIN_CAP) { atomicAdd(&bar[XB_TMO], 1u); break; } }
    }
    nloc = mine > 0u ? mine : 1u; nx = cnt > 0u ? cnt : 1u;
}
__device__ __forceinline__ void xcd_barrier(const XcdBarrier& b) {
    asm volatile("s_waitcnt vmcnt(0)" ::: "memory");
    __syncthreads();
    if (threadIdx.x == 0) {
        unsigned* bar = b.bar;
        __builtin_amdgcn_s_waitcnt(0);
        unsigned nloc = b.st[0], nx = b.st[1];
        if (nloc == 0u) { xcd_barrier_complete(bar, b.x, nloc, nx); b.st[0] = nloc; b.st[1] = nx; }
        const unsigned old = xb_add(&bar[XB_XSUB(b.x)], 1u);
        const unsigned gen = old / nloc;
        if (old + 1u == (gen + 1u) * nloc) {
            __builtin_amdgcn_fence(__ATOMIC_RELEASE, "agent");
            asm volatile("s_waitcnt vmcnt(0)" ::: "memory");
            const unsigned og = xb_add(&bar[XB_TOP], 1u);
            const unsigned tg = og / nx;
            if (og + 1u == (tg + 1u) * nx) xb_add(&bar[XB_TOPGEN], 1u);
            else XB_SPIN(xb_ld(&bar[XB_TOPGEN]) == tg, bar);
            __builtin_amdgcn_fence(__ATOMIC_ACQUIRE, "agent");
            xb_add(&bar[XB_XGEN(b.x)], 1u);
            asm volatile("s_waitcnt vmcnt(0)" ::: "memory");
        } else {
            XB_SPIN(xb_ld(&bar[XB_XGEN(b.x)]) == gen, bar);
            __builtin_amdgcn_fence(__ATOMIC_ACQUIRE, "agent");
            asm volatile("s_waitcnt vmcnt(0)" ::: "memory");
        }
    }
    __syncthreads();
}

__device__ __forceinline__ void tr_load64(const float* W, int ldw, f32x4 (&v)[16], int lane) {
#pragma unroll
    for (int i = 0; i < 16; ++i) { const int kk = 4 * i + (lane >> 4); v[i] = __builtin_nontemporal_load((const f32x4*)(W + (size_t)kk * ldw + (lane & 15) * 4)); }
}
__device__ __forceinline__ void tr_store64(const f32x4 (&v)[16], bf16* WT, int ldt, LAS float* scr, int lane) {
#pragma unroll
    for (int i = 0; i < 16; ++i) { const int kk = 4 * i + (lane >> 4); LAS float* s = scr + kk * 65 + (lane & 15) * 4; s[0] = v[i][0]; s[1] = v[i][1]; s[2] = v[i][2]; s[3] = v[i][3]; }
    LDS_WAIT(); asm volatile("" ::: "memory");
    const int c = lane & 7;
#pragma unroll
    for (int j = 0; j < 8; ++j) { const int n = (lane >> 3) + 8 * j; const LAS float* s = scr + (8 * c) * 65 + n;
        v4u o; o.x = cvt2(s[0], s[65]); o.y = cvt2(s[130], s[195]); o.z = cvt2(s[260], s[325]); o.w = cvt2(s[390], s[455]);
        *(v4u*)(WT + (size_t)n * ldt + 8 * c) = o; }
    LDS_WAIT(); asm volatile("" ::: "memory");
}
#define WinT ((bf16*)(ws + WS_WIN))
#define WabT ((bf16*)(ws + WS_WAB))
#define WB8 ((unsigned char*)(ws + WS_WB8))
#define XN8 ((unsigned char*)(ws + WS_XN8))
#define WQKV8 ((unsigned char*)(ws + WS_WQKV8))
#define PART ((bf16*)(ws + WS_PART))
#define YF8 ((unsigned char*)(ws + WS_YF8))
#define WoT ((bf16*)(ws + WS_WO))
#define WrHi ((bf16*)(ws + WS_WR))
#define WrLo (WrHi + 80 * 2048)
#define XN ((bf16*)(ws + WS_XN))
#define Zb ((bf16*)(ws + WS_Z))
#define XBC ((bf16*)(ws + WS_XBC))
#define Qb ((bf16*)(ws + WS_Q))
#define Kb ((bf16*)(ws + WS_K))
#define Vb ((bf16*)(ws + WS_V))
#define Gb ((bf16*)(ws + WS_G))
#define DTF ((float*)(ws + WS_DTF))
#define XC ((bf16*)(ws + WS_XC))
#define DT ((float*)(ws + WS_DT))
#define CUM ((float*)(ws + WS_CUM))
#define SS ((float*)(ws + WS_SS))
#define AB ((bf16*)(ws + WS_AB))
#define MIX ((bf16*)(ws + WS_MIX))
#define Hf ((bf16*)(ws + WS_H))
#define WguT ((bf16*)(ws + WS_WGU))
#define WdA ((bf16*)(ws + WS_WDA))
#define WdB ((bf16*)(ws + WS_WDB))
#define U2 ((bf16*)(ws + WS_U2))
#define HDN ((bf16*)(ws + WS_HDN))
#define YM ((bf16*)(ws + WS_YM))
#define tok_e ((int*)(ws + WS_TAB + TAB_E))
#define tok_w ((float*)(ws + WS_TAB + TAB_W))
#define tok_rank ((int*)(ws + WS_TAB + TAB_RANK))
#define tok_row ((int*)(ws + WS_TAB + TAB_ROW))
#define tile_tab ((unsigned*)(ws + WS_TAB + TAB_TILE))
#define row_tok ((int*)(ws + WS_TAB + TAB_ROWTOK))
#define ecnt (ctl + CW_CNT)
#define in_x ARGP(0)
#define norm_mix_w ARGP(1)
#define w_in ARGP(2)
#define conv_w ARGP(3)
#define conv_b ARGP(4)
#define dt_bias ARGP(5)
#define a_log ARGP(6)
#define d_skip ARGP(7)
#define ssd_norm_w ARGP(8)
#define fox_f_bias ARGP(9)
#define w_proj_ssd ARGP(10)
#define w_proj_fox ARGP(11)
#define w_out ARGP(12)
#define norm_moe_w ARGP(13)
#define w_rg ARGP(14)
#define b_rg ARGP(15)
#define w_re ARGP(16)
#define b_re ARGP(17)
#define w_gate ARGP(18)
#define w_up ARGP(19)
#define w_down ARGP(20)
#define norm_final_w ARGP(21)
__device__ __forceinline__ void tr_store64_f8(const f32x4 (&v)[16], unsigned char* WT, int ldt, LAS float* scr, int lane, float sc) {
#pragma unroll
    for (int i = 0; i < 16; ++i) { const int kk = 4 * i + (lane >> 4); LAS float* s = scr + kk * 65 + (lane & 15) * 4; s[0] = v[i][0]; s[1] = v[i][1]; s[2] = v[i][2]; s[3] = v[i][3]; }
    LDS_WAIT(); asm volatile("" ::: "memory");
    const int c = lane & 3;
#pragma unroll
    for (int j = 0; j < 4; ++j) { const int n = (lane >> 2) + 16 * j; const LAS float* s = scr + (16 * c) * 65 + n;
        v4u o; o.x = cvt_fp8x4(s[0] * sc, s[65] * sc, s[130] * sc, s[195] * sc); o.y = cvt_fp8x4(s[260] * sc, s[325] * sc, s[390] * sc, s[455] * sc);
        o.z = cvt_fp8x4(s[520] * sc, s[585] * sc, s[650] * sc, s[715] * sc); o.w = cvt_fp8x4(s[780] * sc, s[845] * sc, s[910] * sc, s[975] * sc);
        *(v4u*)(WT + (size_t)n * ldt + 16 * c) = o; }
    LDS_WAIT(); asm volatile("" ::: "memory");
}
typedef const float* cfp_t;
#define ARGP(k) (*(const volatile __attribute__((address_space(4))) cfp_t*)(kin + (k)))
#define CONV_I_G (NEXP * 32 * 8)
#define WGU_PRESCALE 64.0f
#define TR_STORE_ANY(v_, d_, lt_, scr__) do { if ((lt_) < 0) tr_store64_f8(v_, (unsigned char*)(d_), -(lt_), scr__, lane, WGU_PRESCALE); else tr_store64(v_, d_, lt_, scr__, lane); } while (0)
#define EXPERT_DECODE(it_, src_, ldw_, dst_, ldt_) do { int r_ = (it_); \
        if (r_ < 2 * CONV_I_G) { const int isup_ = r_ >= CONV_I_G; if (isup_) r_ -= CONV_I_G; const int e_ = r_ >> 8, kb_ = (r_ >> 3) & 31, nb_ = r_ & 7; \
            src_ = (isup_ ? w_up : w_gate) + ((size_t)e_ * 2048 + 64 * kb_) * 512 + 64 * nb_; ldw_ = 512; \
            dst_ = (bf16*)((unsigned char*)WguT + ((size_t)e_ * 1024 + (nb_ >> 1) * 256 + isup_ * 128 + (nb_ & 1) * 64) * 2048 + 64 * kb_); ldt_ = -2048;   } \
        else { r_ -= 2 * CONV_I_G; const int e_ = r_ >> 8, kb_ = (r_ >> 5) & 7, nb_ = r_ & 31; \
            src_ = w_down + ((size_t)e_ * 512 + 64 * kb_) * 2048 + 64 * nb_; ldw_ = 2048; \
            dst_ = (bf16*)((unsigned char*)(e_ < WD_SPLIT ? WdA : WdB) + (size_t)(e_ < WD_SPLIT ? e_ : e_ - WD_SPLIT) * 2048 * 512 + (size_t)(64 * nb_) * 512 + 64 * kb_); ldt_ = -512;   } } while (0)
#define EXPERT_CONVERT(it_lo, it_hi) EXPERT_CONVERT_S(it_lo, it_hi, gw, NGW)
#define EXPERT_CONVERT_S(it_lo, it_hi, first_, stride_) do { LAS float* scr_ = (LAS float*)(ldsl + wave * 16640); \
        int it0_ = (it_lo) + (first_); \
        if (it0_ < (it_hi)) { const float* s0_; bf16* d0_; int lw0_, lt0_; f32x4 v0_[16]; \
            EXPERT_DECODE(it0_, s0_, lw0_, d0_, lt0_); tr_load64(s0_, lw0_, v0_, lane); \
            for (;;) { const int it1_ = it0_ + (stride_); const bool has1_ = it1_ < (it_hi); const float* s1_ = s0_; bf16* d1_ = d0_; int lw1_ = lw0_, lt1_ = lt0_; f32x4 v1_[16]; \
                if (has1_) { EXPERT_DECODE(it1_, s1_, lw1_, d1_, lt1_); tr_load64(s1_, lw1_, v1_, lane); } \
                TR_STORE_ANY(v0_, d0_, lt0_, scr_); \
                if (!has1_) break; \
                _Pragma("unroll") for (int i_ = 0; i_ < 16; ++i_) v0_[i_] = v1_[i_]; \
                d0_ = d1_; lt0_ = lt1_; s0_ = s1_; lw0_ = lw1_; it0_ = it1_; } } } while (0)
#define CONV_NEXT(var_) do { if (pos_ < end_) { var_ = pos_++; } else { unsigned b_ = 0u; if (lane == 0) b_ = __hip_atomic_fetch_add(cctr_, 4u, RLX_AGENT); b_ = (unsigned)__builtin_amdgcn_readfirstlane((int)b_); \
        if ((int)b_ >= (n_items_)) { var_ = -1; } else { var_ = (int)b_; pos_ = (int)b_ + 1; end_ = ((int)b_ + 4 < (n_items_)) ? (int)b_ + 4 : (n_items_); } } } while (0)
#define EXPERT_CONVERT_DYN(ctr, n_items) do { LAS float* scr_ = (LAS float*)(ldsl + wave * 16640); unsigned* cctr_ = (ctr); const int n_items_ = (n_items); int pos_ = 0, end_ = 0; \
        int it0_; CONV_NEXT(it0_); \
        if (it0_ >= 0) { const float* s0_; bf16* d0_; int lw0_, lt0_; f32x4 v0_[16]; \
            EXPERT_DECODE(it0_, s0_, lw0_, d0_, lt0_); tr_load64(s0_, lw0_, v0_, lane); \
            for (;;) { int it1_; CONV_NEXT(it1_); const bool has1_ = it1_ >= 0; const float* s1_ = s0_; bf16* d1_ = d0_; int lw1_ = lw0_, lt1_ = lt0_; f32x4 v1_[16]; \
                if (has1_) { EXPERT_DECODE(it1_, s1_, lw1_, d1_, lt1_); tr_load64(s1_, lw1_, v1_, lane); } \
                TR_STORE_ANY(v0_, d0_, lt0_, scr_); \
                if (!has1_) break; \
                _Pragma("unroll") for (int i_ = 0; i_ < 16; ++i_) v0_[i_] = v1_[i_]; \
                d0_ = d1_; lt0_ = lt1_; s0_ = s1_; lw0_ = lw1_; } } } while (0)
struct Args { const float* in[22]; float* out; unsigned char* ws; int ph_lo, ph_hi, sub, pad; };
constexpr int NPHASE = 11;

__global__ void __launch_bounds__(512, 2) mega_fwd(Args args) {
    extern __shared__ __attribute__((aligned(16))) unsigned char lds[];
    LAS unsigned char* ldsl = (LAS unsigned char*)lds;
    volatile LAS unsigned* MISC = (volatile LAS unsigned*)(ldsl + MISC_OFF);
    const int tid = threadIdx.x, lane = tid & 63, wave = __builtin_amdgcn_readfirstlane(tid >> 6);
    const int G = gridDim.x, bx = blockIdx.x;
    const int gw = bx * 8 + wave, NGW = G * 8;
    const __attribute__((address_space(4))) cfp_t* kin = (const __attribute__((address_space(4))) cfp_t*)__builtin_amdgcn_kernarg_segment_ptr();
    unsigned char* ws = args.ws;
    unsigned* ctl = (unsigned*)(ws + WS_CTL);
    for (int u = tid; u < (LDS_BYTES - LDSCTL_OFF) / 4; u += 512) ((LAS unsigned*)(ldsl + LDSCTL_OFF))[u] = 0u;
    __syncthreads();
    const int lo = args.ph_lo, hi = args.ph_hi, sub = args.sub;
    XcdBarrier bar; bar.bar = ctl + CW_BAR; bar.x = 0; bar.st = nullptr;
    if (hi - lo > 1) bar = xcd_barrier_post(ctl + CW_BAR, MISC + 8);
#define IN(k) (lo <= (k) && (k) < hi)
#define SEAM(k) do { if (IN(k) && IN((k) + 1)) xcd_barrier(bar); } while (0)

    if (IN(0)) {
        LAS float* scr = (LAS float*)(ldsl + wave * 16640);
        constexpr int I_Z = 32 * 32, I_XBC = 32 * 48, I_QKV = 32 * 96, I_GS = 32 * 32, I_GF = 32 * 32, I_SQ = 32 * 32;
        constexpr int NITEMS = I_Z + I_XBC + I_QKV + I_GS + I_GF + 3 * I_SQ;
#define P0_DECODE(it_, srcp_, ldw_, dstp_, ldt_) do { int r = (it_); const float* src; int nb_per; bf16* dst; \
            if (r < I_Z) { src = w_in + SRC_Z; ldw_ = NPROJ; dst = WinT + (size_t)DST_Z * 2048; ldt_ = 2048; nb_per = 32; } \
            else if ((r -= I_Z) < I_XBC) { src = w_in + SRC_XBC; ldw_ = NPROJ; dst = WinT + (size_t)DST_XBC * 2048; ldt_ = 2048; nb_per = 48; } \
            else if ((r -= I_XBC) < I_QKV) { src = w_in + SRC_QKV; ldw_ = NPROJ; dst = (bf16*)WQKV8; ldt_ = -2048; nb_per = 96; }        \
            else if ((r -= I_QKV) < I_GS) { src = w_in + SRC_GATE; ldw_ = NPROJ; dst = WinT + (size_t)DST_GATE * 2048; ldt_ = 2048; nb_per = 32; }        \
            else if ((r -= I_GS) < I_GF) { src = w_in + SRC_GATE + 2048; ldw_ = NPROJ; dst = (bf16*)(WQKV8 + (size_t)6144 * 2048); ldt_ = -2048; nb_per = 32; }        \
            else if ((r -= I_GF) < I_SQ) { src = w_proj_ssd; ldw_ = 2048; dst = WabT; ldt_ = 4096; nb_per = 32; } \
            else if ((r -= I_SQ) < I_SQ) { src = w_proj_fox; ldw_ = 2048; dst = (bf16*)WB8; ldt_ = -2048; nb_per = 32; }        \
            else { r -= I_SQ; src = w_out; ldw_ = 2048; dst = WoT; ldt_ = 2048; nb_per = 32; } \
            const int kb = r / nb_per, nb = r % nb_per; srcp_ = src + (size_t)(64 * kb) * ldw_ + 64 * nb; \
            dstp_ = ldt_ < 0 ? (bf16*)((unsigned char*)dst + (size_t)(64 * nb) * (size_t)(-ldt_) + 64 * kb) : dst + (size_t)(64 * nb) * ldt_ + 64 * kb; } while (0)
        { int itc = gw;
          if (itc < NITEMS) { const float* sc; bf16* dc; int lwc, ltc; f32x4 vc[16]; P0_DECODE(itc, sc, lwc, dc, ltc); tr_load64(sc, lwc, vc, lane);
            for (;;) { const int itn = itc + NGW; const bool more = itn < NITEMS; const float* sn = sc; bf16* dn = dc; int lwn = lwc, ltn = ltc; f32x4 vn[16];
                if (more) { P0_DECODE(itn, sn, lwn, dn, ltn); tr_load64(sn, lwn, vn, lane); }
                TR_STORE_ANY(vc, dc, ltc, scr);
                if (!more) break;
#pragma unroll
                for (int i = 0; i < 16; ++i) vc[i] = vn[i];
                itc = itn; sc = sn; dc = dn; lwc = lwn; ltc = ltn; } } }
#undef P0_DECODE
        for (int idx = bx * 512 + tid; idx < 48 * 2048; idx += G * 512) { const int r = idx >> 11, k = idx & 2047;
            const float v = (r < 32) ? w_in[(size_t)k * NPROJ + SRC_DT + r] : w_in[(size_t)k * NPROJ + SRC_F + (r - 32)];
            WinT[(size_t)(DST_SMALL + r) * 2048 + k] = (bf16)f2bf(v); }
        for (int idx = bx * 512 + tid; idx < 80 * 2048; idx += G * 512) { const int r = idx >> 11, k = idx & 2047;
            float v = 0.f; if (r < 8) v = w_rg[(size_t)k * 8 + r]; else if (r < 72) v = w_re[(size_t)k * 64 + (r - 8)];
            const unsigned hb = f2bf(v); WrHi[idx] = (bf16)hb; WrLo[idx] = (bf16)f2bf(v - bf2f(hb)); }
        { f32x4 xv[2][8];
#define P0_LOAD(S_, m_) do { const f32x4* xr_ = (const f32x4*)(in_x + (size_t)(m_) * DM); \
            _Pragma("unroll") for (int j_ = 0; j_ < 4; ++j_) { xv[S_][2 * j_] = __builtin_nontemporal_load(xr_ + (j_ * 64 + lane) * 2); xv[S_][2 * j_ + 1] = __builtin_nontemporal_load(xr_ + (j_ * 64 + lane) * 2 + 1); } } while (0)
          int m = gw; if (m < T) P0_LOAD(0, m);
          for (int it = 0; m < T; m += NGW, ++it) {
#pragma unroll
            for (int par = 0; par < 2; ++par) { if ((it & 1) == par) {
              if (m + NGW < T) P0_LOAD(par ^ 1, m + NGW);
              float sacc = 0.f;
#pragma unroll
              for (int j = 0; j < 8; ++j) { const f32x4 q = xv[par][j]; sacc += (q[0] * q[0] + q[1] * q[1]) + (q[2] * q[2] + q[3] * q[3]); }
              const float rstd = 1.0f / sqrtf(wave_sum(sacc) * (1.f / DM) + EPS);
#pragma unroll
              for (int j = 0; j < 4; ++j) { const f32x4* wp = (const f32x4*)(norm_mix_w) + (j * 64 + lane) * 2; const f32x4 w0 = wp[0], w1 = wp[1]; const f32x4 a = xv[par][2 * j] * rstd * w0, bq = xv[par][2 * j + 1] * rstd * w1;
                  v4u o; o.x = pk2(a[0], a[1]); o.y = pk2(a[2], a[3]); o.z = pk2(bq[0], bq[1]); o.w = pk2(bq[2], bq[3]);
                  *(v4u*)(XN + (size_t)m * DM + (j * 64 + lane) * 8) = o;
                  const f32x4 a8 = a * XN_SCALE, b8 = bq * XN_SCALE;
                  *(v2u*)(XN8 + (size_t)m * DM + (j * 64 + lane) * 8) = (v2u){cvt_fp8x4(a8[0], a8[1], a8[2], a8[3]), cvt_fp8x4(b8[0], b8[1], b8[2], b8[3])}; }
            } }
          }
#undef P0_LOAD
        }
    }
    SEAM(0);

    if (IN(1)) {
        { pg8::Shape g{2048, 2048, 2048};
          pg8::SchedCols S{(const char*)XN, (const char*)WinT, T / 256, 28, G, bx, (size_t)256 * 2048 * 2, (size_t)256 * 2048 * 2, 0, 20, 24, true};
          pg8::EpiProj E{Zb, XBC, Qb, Kb, Vb, Gb, (LAS float*)(ldsl + pg8::STAGE_BYTES), ctl + CW_QM, ctl + CW_KM, 1.0f};
          pg8::gemm_phase<pg8::EpiProj, pg8::SchedCols, true>(ldsl, g, S, E); }
        __syncthreads();
        { pg8::Shape g{1024, 1024, 1024};
          pg8::SchedCols S{(const char*)XN8, (const char*)WQKV8, T / 256, 32, G, bx, (size_t)256 * 2048, (size_t)256 * 2048, 20, 24, 8, false};
          pg8::EpiProj E{Zb, XBC, Qb, Kb, Vb, Gb, (LAS float*)(ldsl + pg8::STAGE_BYTES), ctl + CW_QM, ctl + CW_KM, 1.0f / (WGU_PRESCALE * XN_SCALE)};
          pg8::gemm_phase<pg8::EpiProj, pg8::SchedCols, true, false, true>(ldsl, g, S, E); }
        for (int item = gw; item < (T / 16) * 2; item += NGW) { const int tile = item >> 1, kh = item & 1;
            const bf16* ap = XN + (size_t)(tile * 16 + (lane & 15)) * 2048 + kh * 1024 + 8 * (lane >> 4);
            const bf16* bp = WinT + (size_t)(DST_SMALL + (lane & 15)) * 2048 + kh * 1024 + 8 * (lane >> 4);
            f32x4 acc[3]; acc[0] = (f32x4){0.f, 0.f, 0.f, 0.f}; acc[1] = acc[0]; acc[2] = acc[0];
#pragma unroll 8
            for (int ks = 0; ks < 32; ++ks) { const bf16x8 a = *(const bf16x8*)(ap + ks * 32);
#pragma unroll
                for (int ct = 0; ct < 3; ++ct) { const bf16x8 bb = *(const bf16x8*)(bp + (size_t)ct * 16 * 2048 + ks * 32); acc[ct] = __builtin_amdgcn_mfma_f32_16x16x32_bf16(a, bb, acc[ct], 0, 0, 0); } }
            float* dp = DTF + (size_t)kh * T * 64 + (size_t)(tile * 16 + (lane >> 4) * 4) * 64 + (lane & 15);
#pragma unroll
            for (int ct = 0; ct < 3; ++ct)
#pragma unroll
                for (int r = 0; r < 4; ++r) dp[r * 64 + ct * 16] = acc[ct][r]; }
    }
    SEAM(1);

    if (IN(2)) {
        { v4u rw[2][11];
#define CV_LOAD(S_, idx_) do { const int tb_ = (idx_) / 384, c8_ = (idx_) - tb_ * 384, t0_ = tb_ * 8, s0_ = t0_ & (SEQ - 1); \
            _Pragma("unroll") for (int j_ = 0; j_ < 11; ++j_) { if (j_ >= 3 || s0_ > 0) rw[S_][j_] = *(const v4u*)(XBC + (size_t)(t0_ - 3 + j_) * CONVD + c8_ * 8); else rw[S_][j_] = (v4u){0u, 0u, 0u, 0u}; } } while (0)
          const int NIT = (T / 8) * 384, step = G * 512;
          int idx = bx * 512 + tid; if (idx < NIT) CV_LOAD(0, idx);
          for (int it = 0; idx < NIT; idx += step, ++it) {
#pragma unroll
            for (int par = 0; par < 2; ++par) { if ((it & 1) == par) {
              if (idx + step < NIT) CV_LOAD(par ^ 1, idx + step);
              const int tb = idx / 384, c8 = idx - tb * 384, ch = c8 * 8, t0 = tb * 8;
              float wt[4][8], bs[8];
#pragma unroll
              for (int w = 0; w < 4; ++w) { const f32x4 w0 = *(const f32x4*)(conv_w + w * CONVD + ch), w1 = *(const f32x4*)(conv_w + w * CONVD + ch + 4);
                  wt[w][0] = w0[0]; wt[w][1] = w0[1]; wt[w][2] = w0[2]; wt[w][3] = w0[3]; wt[w][4] = w1[0]; wt[w][5] = w1[1]; wt[w][6] = w1[2]; wt[w][7] = w1[3]; }
              { const f32x4 b0 = *(const f32x4*)(conv_b + ch), b1 = *(const f32x4*)(conv_b + ch + 4); bs[0] = b0[0]; bs[1] = b0[1]; bs[2] = b0[2]; bs[3] = b0[3]; bs[4] = b1[0]; bs[5] = b1[1]; bs[6] = b1[2]; bs[7] = b1[3]; }
#pragma unroll
              for (int o = 0; o < 8; ++o) { float a[8];
#pragma unroll
                  for (int e = 0; e < 8; ++e) a[e] = bs[e];
#pragma unroll
                  for (int w = 0; w < 4; ++w) { const v4u r = rw[par][o + w];
                      a[0] += wt[w][0] * bflo(r.x); a[1] += wt[w][1] * bfhi(r.x); a[2] += wt[w][2] * bflo(r.y); a[3] += wt[w][3] * bfhi(r.y);
                      a[4] += wt[w][4] * bflo(r.z); a[5] += wt[w][5] * bfhi(r.z); a[6] += wt[w][6] * bflo(r.w); a[7] += wt[w][7] * bfhi(r.w); }
#pragma unroll
                  for (int e = 0; e < 8; ++e) a[e] = siluf_(a[e]);
                  v4u ov; ov.x = cvt2(a[0], a[1]); ov.y = cvt2(a[2], a[3]); ov.z = cvt2(a[4], a[5]); ov.w = cvt2(a[6], a[7]);
                  *(v4u*)(XC + (size_t)(t0 + o) * CONVD + ch) = ov; }
            } }
          }
#undef CV_LOAD
        }
        for (int idx = bx * 512 + tid; idx < T * 32; idx += G * 512) { const int h = idx & 31, t = idx >> 5;
            const float v = DTF[(size_t)t * 64 + h] + DTF[(size_t)T * 64 + (size_t)t * 64 + h] + dt_bias[h];
            DT[((size_t)(t >> 12) * 32 + h) * SEQ + (t & (SEQ - 1))] = fmaxf(v, 0.f) + log1pf(__expf(-fabsf(v))); }
        if (wave == 7) for (int sid = bx; sid < 64; sid += G) { const int b = sid >> 4, hh = sid & 15; const float fb = fox_f_bias[hh];
            const float* src = DTF + ((size_t)b * SEQ + (size_t)lane * 64) * 64 + 32 + hh; float v[64];
#pragma unroll
            for (int i = 0; i < 64; ++i) v[i] = src[(size_t)i * 64] + src[(size_t)T * 64 + (size_t)i * 64];
            float run = 0.f;
#pragma unroll
            for (int i = 0; i < 64; ++i) { const float z = v[i] + fb; run += -(fmaxf(-z, 0.f) + log1pf(__expf(-fabsf(z)))); v[i] = run; }
            float tot = run;
#pragma unroll
            for (int o = 1; o < 64; o <<= 1) { const float n = __shfl_up(tot, o); if (lane >= o) tot += n; }
            const float base = tot - run;
            float* dst = CUM + (size_t)sid * SEQ + lane * 64;
#pragma unroll
            for (int i = 0; i < 64; i += 4) *(f32x4*)(dst + i) = (f32x4){v[i] + base, v[i + 1] + base, v[i + 2] + base, v[i + 3] + base}; }
    }
    SEAM(2);

    if (IN(3)) {
        constexpr int CONV_P3_END = 2 * CONV_I_G + WD_SPLIT * 256;
        const int GH = G >> 1;
        if ((sub & 2) && bx < GH) {
            constexpr int RS = 272, XSt = 144;
            LAS unsigned char* Cs = ldsl; LAS unsigned char* Bs = ldsl + 34816; LAS unsigned char* Ms = Cs;
            LAS unsigned char* Xs = ldsl + 69632; LAS unsigned char* XWs = ldsl + 88064; LAS unsigned char* S16 = ldsl + 106496;
            LAS float* A2 = (LAS float*)(ldsl + 123904 + wave * 1536); LAS float* LW2 = A2 + 128; LAS float* WW = A2 + 256;
            const int l15 = lane & 15, g4 = lane >> 4, r32 = lane & 31, hi5 = lane >> 5, trq = (lane & 15) >> 2, trp = lane & 3;
            const int prow = tid >> 4, pcol = tid & 15, xrow = tid >> 3, xc8 = tid & 7;
            typedef short v4i16_t __attribute__((ext_vector_type(4)));
            constexpr float L2E = 1.4426950408889634f;
#define SSD_TR(p) __builtin_amdgcn_ds_read_tr16_b64_v4i16((LAS v4i16_t*)(p))
#define SSD_MFMA16(a, b, c) __builtin_amdgcn_mfma_f32_16x16x32_bf16(a, b, c, 0, 0, 0)
            for (int unit0 = bx; unit0 < NB * SSD_H; unit0 += GH) {
                const int unit = (GH == 128) ? ((((unit0 & 7) * 2 + ((unit0 >> 3) >> 3)) << 3) | ((unit0 >> 3) & 7)) : unit0;
                const int b = unit >> 5, h = unit & 31, g = h >> 3;
                const float ah = -__expf(a_log[h]), Dh = d_skip[h];
                const int chx = h * 64;
                float nwv[4];
#pragma unroll
                for (int pt = 0; pt < 4; ++pt) nwv[pt] = ssd_norm_w[chx + 16 * pt + l15];
                f32x4 Sacc[4];
#pragma unroll
                for (int pt = 0; pt < 4; ++pt) Sacc[pt] = (f32x4){0.f, 0.f, 0.f, 0.f};
                const unsigned cvo0 = (unsigned)(prow * CONVD + pcol * 8) * 2u, xvo0 = (unsigned)(xrow * CONVD + xc8 * 8) * 2u, dvo0 = (unsigned)lane * 8u;
                const unsigned zvo0 = (unsigned)((16 * wave + 4 * g4) * 2048 + l15) * 2u, ovo0 = (unsigned)((16 * wave + 4 * g4) * 4096 + l15) * 2u, svo0 = (unsigned)(16 * wave + 4 * g4 + l15) * 128u;
                unsigned cvo = cvo0, xvo = xvo0, dvo = dvo0, zvo = zvo0, ovo = ovo0, svo = svo0;
#define SSD_OPAQUE() asm volatile("" : "+v"(cvo), "+v"(xvo), "+v"(dvo), "+v"(zvo), "+v"(ovo), "+v"(svo))
                v4u cst[4], bst[4], xst[2]; float dt0, dt1, tot_cur = 0.f; unsigned short zn[16], zr[16];
#define SSD_LOAD(cc) do { const size_t tb_ = (size_t)b * SEQ + (size_t)(cc) * 128; \
                    const char* cb_ = (const char*)(XC + tb_ * CONVD + 2560 + g * 128); const char* bb_ = (const char*)(XC + tb_ * CONVD + 2048 + g * 128); \
                    _Pragma("unroll") for (int i_ = 0; i_ < 4; ++i_) { cst[i_] = *(const v4u*)(cb_ + (size_t)i_ * (32 * CONVD * 2) + cvo); bst[i_] = *(const v4u*)(bb_ + (size_t)i_ * (32 * CONVD * 2) + cvo); } \
                    { const char* xb_ = (const char*)(XC + tb_ * CONVD + chx); xst[0] = *(const v4u*)(xb_ + xvo); xst[1] = *(const v4u*)(xb_ + (size_t)(64 * CONVD * 2) + xvo); } \
                    { const f32x2_t d2_ = *(const f32x2_t*)((const char*)(DT + ((size_t)b * 32 + h) * SEQ + (size_t)(cc) * 128) + dvo); dt0 = d2_[0]; dt1 = d2_[1]; } } while (0)
#define SSD_ZLOAD(dst, cc) do { const char* zp_ = (const char*)(Zb + ((size_t)b * SEQ + (size_t)(cc) * 128) * 2048 + chx); \
                    _Pragma("unroll") for (int pt_ = 0; pt_ < 4; ++pt_) _Pragma("unroll") for (int r_ = 0; r_ < 4; ++r_) dst[pt_ * 4 + r_] = *(const bf16*)(zp_ + (r_ * 4096 + 32 * pt_) + zvo); } while (0)
#define SSD_WRITE() do { const float a0_ = dt0 * ah, a1_ = a0_ + dt1 * ah; const float inc_ = wave_incl_scan(a1_); \
                    const float ex_ = inc_ - a1_, c0_ = ex_ + a0_, c1_ = inc_; const float tot_ = __builtin_bit_cast(float, __builtin_amdgcn_readlane(__builtin_bit_cast(int, inc_), 63)); tot_cur = tot_; \
                    *(LAS f32x2_t*)(A2 + 2 * lane) = (f32x2_t){c0_ * L2E, c1_ * L2E}; \
                    *(LAS f32x2_t*)(LW2 + 2 * lane) = (f32x2_t){__log2f(dt0) - c0_ * L2E, __log2f(dt1) - c1_ * L2E}; \
                    *(LAS f32x2_t*)(WW + 2 * lane) = (f32x2_t){dt0 * __expf(tot_ - c0_), dt1 * __expf(tot_ - c1_)}; \
                    _Pragma("unroll") for (int i_ = 0; i_ < 4; ++i_) { *(LAS v4u*)(Cs + (prow + 32 * i_) * RS + pcol * 16) = cst[i_]; *(LAS v4u*)(Bs + (prow + 32 * i_) * RS + pcol * 16) = bst[i_]; } \
                    _Pragma("unroll") for (int i_ = 0; i_ < 2; ++i_) { const int xr_ = xrow + 64 * i_; const v4u xs_ = xst[i_]; const float wv_ = WW[xr_]; v4u xw_; \
                      xw_.x = cvt2(bflo(xs_.x) * wv_, bfhi(xs_.x) * wv_); xw_.y = cvt2(bflo(xs_.y) * wv_, bfhi(xs_.y) * wv_); xw_.z = cvt2(bflo(xs_.z) * wv_, bfhi(xs_.z) * wv_); xw_.w = cvt2(bflo(xs_.w) * wv_, bfhi(xs_.w) * wv_); \
                      *(LAS v4u*)(Xs + xr_ * XSt + xc8 * 16) = xs_; *(LAS v4u*)(XWs + xr_ * XSt + xc8 * 16) = xw_; } } while (0)
                __syncthreads();
                SSD_ZLOAD(zr, 0);
                SSD_LOAD(0);
                for (int q = tid; q < 64 * RS / 4; q += 512) ((LAS unsigned*)S16)[q] = 0u;
                SSD_WRITE();
                __syncthreads();
                for (int c = 0; c < 32; ++c) {
                    const size_t t0 = (size_t)b * SEQ + (size_t)c * 128;
                    SSD_OPAQUE();
                    if (c + 1 < 32) { SSD_ZLOAD(zn, c + 1); SSD_LOAD(c + 1); }
                    f32x4 yo[4], yd[4];
#pragma unroll
                    for (int pt = 0; pt < 4; ++pt) { yo[pt] = (f32x4){0.f, 0.f, 0.f, 0.f}; yd[pt] = yo[pt]; }
#pragma unroll
                    for (int ks = 0; ks < 4; ++ks) { const bf16x8 a = *(const LAS bf16x8*)(Cs + (16 * wave + l15) * RS + (ks * 32 + 8 * g4) * 2);
#pragma unroll
                        for (int pt = 0; pt < 4; ++pt) { const bf16x8 bb = *(const LAS bf16x8*)(S16 + (16 * pt + l15) * RS + (ks * 32 + 8 * g4) * 2); yo[pt] = SSD_MFMA16(a, bb, yo[pt]); } }
                    const int st = wave >> 1; f32x16 pg[2];
#pragma unroll
                    for (int j = 0; j < 2; ++j) { const int lt = 2 * (wave & 1) + j;
#pragma unroll
                        for (int r = 0; r < 16; ++r) pg[j][r] = 0.f;
                        if (lt >= st) {
#pragma unroll
                            for (int kk = 0; kk < 8; ++kk) { const bf16x8 a = *(const LAS bf16x8*)(Bs + (32 * st + r32) * RS + (kk * 16 + 8 * hi5) * 2), bb = *(const LAS bf16x8*)(Cs + (32 * lt + r32) * RS + (kk * 16 + 8 * hi5) * 2);
                                pg[j] = __builtin_amdgcn_mfma_f32_32x32x16_bf16(a, bb, pg[j], 0, 0, 0); } } }
                    LDS_BARRIER();
#pragma unroll
                    for (int j = 0; j < 2; ++j) { const int lt = 2 * (wave & 1) + j; const int l = 32 * lt + r32;
                        if (lt >= st) { const float acl = A2[l];
#pragma unroll
                            for (int rg = 0; rg < 4; ++rg) { const int sb = 32 * st + 8 * rg + 4 * hi5; const f32x4 lw = *(const LAS f32x4*)(LW2 + sb);
                                float m[4];
#pragma unroll
                                for (int i = 0; i < 4; ++i) { m[i] = pg[j][4 * rg + i] * __builtin_amdgcn_exp2f(acl + lw[i]); if (lt == st && sb + i > l) m[i] = 0.f; }
                                v2u w; w.x = cvt2(m[0], m[1]); w.y = cvt2(m[2], m[3]); *(LAS v2u*)(Ms + l * RS + sb * 2) = w; } } }
                    LDS_BARRIER();
#pragma unroll
                    for (int ks = 0; ks < 4; ++ks) { if (32 * ks <= 16 * wave + 15) { const bf16x8 a = *(const LAS bf16x8*)(Ms + (16 * wave + l15) * RS + (ks * 32 + 8 * g4) * 2);
#pragma unroll
                        for (int pt = 0; pt < 4; ++pt) { LAS unsigned char* xa = Xs + (ks * 32 + 8 * g4 + trq) * XSt + (16 * pt + 4 * trp) * 2; const v4i16_t lo = SSD_TR(xa), hh = SSD_TR(xa + 4 * XSt);
                            const bf16x8 bb = {lo[0], lo[1], lo[2], lo[3], hh[0], hh[1], hh[2], hh[3]}; yd[pt] = SSD_MFMA16(a, bb, yd[pt]); } } }
                    { const f32x4 acv = *(const LAS f32x4*)(A2 + 16 * wave + 4 * g4); float sq[4] = {0.f, 0.f, 0.f, 0.f};
                      char* op = (char*)(AB + t0 * 4096 + chx);
                      unsigned short xr[16];
#pragma unroll
                      for (int r = 0; r < 4; ++r)
#pragma unroll
                          for (int pt = 0; pt < 4; ++pt) xr[r * 4 + pt] = *(const LAS bf16*)(Xs + (16 * wave + 4 * g4 + r) * XSt + (16 * pt + l15) * 2);
#pragma unroll
                      for (int r = 0; r < 4; ++r) { const float ea = __builtin_amdgcn_exp2f(acv[r]);
#pragma unroll
                          for (int pt = 0; pt < 4; ++pt) {
                              const float xv = bf2f(xr[r * 4 + pt]);
                              const float y = yd[pt][r] + ea * yo[pt][r] + Dh * xv;
                              const float gv = y * siluf_(bf2f(zr[pt * 4 + r])); sq[r] += gv * gv;
                              *(bf16*)(op + (r * 8192 + 32 * pt) + ovo) = (bf16)(cvt2(gv * nwv[pt], 0.f) & 0xffffu); } }
                      { const float s0 = row16_sum(sq[0]), s1 = row16_sum(sq[1]), s2 = row16_sum(sq[2]), s3 = row16_sum(sq[3]);
                        if (l15 < 4) *(float*)((char*)(SS + t0 * 32 + h) + svo) = l15 == 0 ? s0 : l15 == 1 ? s1 : l15 == 2 ? s2 : s3; } }
                    { const float cd = __expf(tot_cur);
#pragma unroll
                      for (int pt = 0; pt < 4; ++pt) Sacc[pt] = Sacc[pt] * cd;
#pragma unroll
                      for (int ks = 0; ks < 4; ++ks) { LAS unsigned char* ba = Bs + (ks * 32 + 8 * g4 + trq) * RS + (16 * wave + 4 * trp) * 2; const v4i16_t bl = SSD_TR(ba), bh = SSD_TR(ba + 4 * RS);
                          const bf16x8 bb = {bl[0], bl[1], bl[2], bl[3], bh[0], bh[1], bh[2], bh[3]};
#pragma unroll
                          for (int pt = 0; pt < 4; ++pt) { LAS unsigned char* xa = XWs + (ks * 32 + 8 * g4 + trq) * XSt + (16 * pt + 4 * trp) * 2; const v4i16_t al = SSD_TR(xa), ahh = SSD_TR(xa + 4 * XSt);
                              const bf16x8 aa = {al[0], al[1], al[2], al[3], ahh[0], ahh[1], ahh[2], ahh[3]}; Sacc[pt] = SSD_MFMA16(aa, bb, Sacc[pt]); } }
#pragma unroll
                      for (int pt = 0; pt < 4; ++pt)
#pragma unroll
                          for (int r = 0; r < 4; ++r) *(LAS bf16*)(S16 + (16 * pt + 4 * g4 + r) * RS + (16 * wave + l15) * 2) = (bf16)(cvt2(Sacc[pt][r], 0.f) & 0xffffu); }
                    LDS_BARRIER();
                    if (c + 1 < 32) { SSD_WRITE();
#pragma unroll
                        for (int i = 0; i < 16; ++i) zr[i] = zn[i]; }
                    LDS_BARRIER();
                }
            }
#undef SSD_LOAD
#undef SSD_OPAQUE
#undef SSD_ZLOAD
#undef SSD_WRITE
#undef SSD_TR
#undef SSD_MFMA16
            __syncthreads();
        }
        if (sub & 1) att::attn_phase((char*)lds, Qb, Kb, Vb, YF8, CUM, ctl + CW_AQ, ctl + CW_QM, ctl + CW_KM, bx & 7, (sub >> 8) & 3);
        if (sub & 4) { __syncthreads(); EXPERT_CONVERT_DYN(ctl + CW_CQ, CONV_P3_END); __syncthreads(); }
    }
    SEAM(3);

    if (IN(4)) {
        { pg8::Shape g{2048, 4096, 4096};
          pg8::SchedPlain S{(const char*)AB, (const char*)WabT, T / 256, 2048 / 256, G, bx, (size_t)256 * 4096 * 2, (size_t)256 * 4096 * 2};
          pg8::EpiMixA E{Gb, SS, PART, (LAS float*)(ldsl + pg8::STAGE_BYTES)};
          pg8::gemm_phase<pg8::EpiMixA, pg8::SchedPlain, true>(ldsl, g, S, E); }
        __syncthreads();
        { pg8::Shape g{1024, 1024, 1024};
          pg8::SchedPlain S{(const char*)YF8, (const char*)WB8, T / 256, 2048 / 256, G, bx, (size_t)256 * 2048, (size_t)256 * 2048};
          pg8::EpiMixB E{Gb, PART, MIX, 1.0f / (WGU_PRESCALE * YF_SCALE)};
          pg8::gemm_phase<pg8::EpiMixB, pg8::SchedPlain, true, false, true>(ldsl, g, S, E); }
    }
    SEAM(4);

    if (IN(5)) {
        pg8::Shape g{2048, 2048, 2048};
        pg8::SchedPlain S{(const char*)MIX, (const char*)WoT, T / 256, 2048 / 256, G, bx, (size_t)256 * 2048 * 2, (size_t)256 * 2048 * 2};
        pg8::EpiRes E{in_x, Hf};
        pg8::gemm_phase<pg8::EpiRes, pg8::SchedPlain, true>(ldsl, g, S, E);
    }
    SEAM(5);

    if (IN(6)) {
        for (int q = bx * 512 + tid; q < MAXROWS; q += G * 512) row_tok[q] = -1;
        if (sub & 8) {
            constexpr int UST = 136;
            LAS bf16* Uhi = (LAS bf16*)(ldsl); LAS bf16* Ulo = Uhi + 64 * UST; LAS bf16* Whi = Ulo + 64 * UST; LAS bf16* Wlo = Whi + 80 * UST;
            LAS float* RS = (LAS float*)(ldsl + 81920); LAS float* LG = (LAS float*)(ldsl + 82944);
            LAS unsigned* LCNT = (LAS unsigned*)(ldsl + 104448); LAS unsigned* LBASE = LCNT + 64;
            for (int tb = bx; tb < T / 64; tb += G) {
                const int t0 = tb * 64;
                __syncthreads();
                if (tid < 64) LCNT[tid] = 0u;
                v4u hrw[8][4];
#pragma unroll
                for (int q = 0; q < 8; ++q) { const v4u* hr = (const v4u*)(Hf + (size_t)(t0 + wave * 8 + q) * DM);
#pragma unroll
                    for (int j = 0; j < 4; ++j) hrw[q][j] = hr[j * 64 + lane]; }
#pragma unroll
                for (int q = 0; q < 8; ++q) { const int tk = wave * 8 + q; float s = 0.f;
#pragma unroll
                    for (int j = 0; j < 4; ++j) { const v4u v = hrw[q][j]; const float a0 = bflo(v.x), a1 = bfhi(v.x), a2 = bflo(v.y), a3 = bfhi(v.y), a4 = bflo(v.z), a5 = bfhi(v.z), a6 = bflo(v.w), a7 = bfhi(v.w);
                        s += ((a0 * a0 + a1 * a1) + (a2 * a2 + a3 * a3)) + ((a4 * a4 + a5 * a5) + (a6 * a6 + a7 * a7)); }
                    s = wave_sum(s); if (lane == 0) RS[tk] = 1.0f / sqrtf(s * (1.f / DM) + EPS); }
                f32x4 acc[3];
#pragma unroll
                for (int i = 0; i < 3; ++i) acc[i] = (f32x4){0.f, 0.f, 0.f, 0.f};
                v4u hq0[2], hq1[2], wq[2][6]; f32x4 nwq[2][4];
                const int ptk = tid >> 3, pkq = (tid & 7) * 16;
#define RT_LOAD(S_, kc_) do { const int k0_ = (kc_) * 128; const v4u* hp_ = (const v4u*)(Hf + (size_t)(t0 + ptk) * DM + k0_ + pkq); hq0[S_] = hp_[0]; hq1[S_] = hp_[1]; \
                    const f32x4* wp_ = (const f32x4*)(norm_moe_w + k0_ + pkq); nwq[S_][0] = wp_[0]; nwq[S_][1] = wp_[1]; nwq[S_][2] = wp_[2]; nwq[S_][3] = wp_[3]; \
                    _Pragma("unroll") for (int i_ = 0; i_ < 3; ++i_) { const int q_ = tid + 512 * i_; if (q_ < 80 * 16) { const int r_ = q_ >> 4, c_ = (q_ & 15) * 8; \
                        wq[S_][2 * i_] = *(const v4u*)(WrHi + (size_t)r_ * 2048 + k0_ + c_); wq[S_][2 * i_ + 1] = *(const v4u*)(WrLo + (size_t)r_ * 2048 + k0_ + c_); } } } while (0)
                RT_LOAD(0, 0); RT_LOAD(1, 1);
                for (int kc2 = 0; kc2 < 16; kc2 += 2) {
#pragma unroll
                  for (int par = 0; par < 2; ++par) {
                    const int kc = kc2 + par, k0 = kc * 128;
                    LDS_BARRIER();
                    { const int tk = ptk, kq = pkq; const float rs = RS[tk];
                      const f32x4 hv[4] = {(f32x4){bflo(hq0[par].x), bfhi(hq0[par].x), bflo(hq0[par].y), bfhi(hq0[par].y)}, (f32x4){bflo(hq0[par].z), bfhi(hq0[par].z), bflo(hq0[par].w), bfhi(hq0[par].w)},
                                           (f32x4){bflo(hq1[par].x), bfhi(hq1[par].x), bflo(hq1[par].y), bfhi(hq1[par].y)}, (f32x4){bflo(hq1[par].z), bfhi(hq1[par].z), bflo(hq1[par].w), bfhi(hq1[par].w)}};
                      unsigned hw[8], lw[8], f8w[4];
#pragma unroll
                      for (int j = 0; j < 4; ++j) { const f32x4 u = hv[j] * rs * nwq[par][j]; f8w[j] = cvt_fp8x4(u[0], u[1], u[2], u[3]);
                          const unsigned h0 = f2bf(u[0]), h1 = f2bf(u[1]), h2 = f2bf(u[2]), h3 = f2bf(u[3]);
                          hw[2 * j] = h0 | (h1 << 16); hw[2 * j + 1] = h2 | (h3 << 16);
                          lw[2 * j] = pk2(u[0] - bf2f(h0), u[1] - bf2f(h1)); lw[2 * j + 1] = pk2(u[2] - bf2f(h2), u[3] - bf2f(h3)); }
                      const v4u H0 = {hw[0], hw[1], hw[2], hw[3]}, H1 = {hw[4], hw[5], hw[6], hw[7]}, L0 = {lw[0], lw[1], lw[2], lw[3]}, L1 = {lw[4], lw[5], lw[6], lw[7]};
                      *(LAS v4u*)(Uhi + tk * UST + kq) = H0; *(LAS v4u*)(Uhi + tk * UST + kq + 8) = H1;
                      *(LAS v4u*)(Ulo + tk * UST + kq) = L0; *(LAS v4u*)(Ulo + tk * UST + kq + 8) = L1;
                      *(v4u*)((unsigned char*)U2 + (size_t)(t0 + tk) * DM + k0 + kq) = (v4u){f8w[0], f8w[1], f8w[2], f8w[3]}; }
#pragma unroll
                    for (int i = 0; i < 3; ++i) { const int q = tid + 512 * i; if (q < 80 * 16) { const int r = q >> 4, c = (q & 15) * 8;
                        *(LAS v4u*)(Whi + r * UST + c) = wq[par][2 * i]; *(LAS v4u*)(Wlo + r * UST + c) = wq[par][2 * i + 1]; } }
                    if (kc + 2 < 16) RT_LOAD(par, kc + 2);
                    LDS_BARRIER();
#pragma unroll
                    for (int i = 0; i < 3; ++i) { const int tile = wave + 8 * i;
                        if (tile < 20) { const int tt = tile / 5, ct = tile - tt * 5;
#pragma unroll
                            for (int ks = 0; ks < 4; ++ks) { const int ko = ks * 32 + 8 * (lane >> 4);
                                const bf16x8 ah = *(const LAS bf16x8*)(Uhi + (tt * 16 + (lane & 15)) * UST + ko), al = *(const LAS bf16x8*)(Ulo + (tt * 16 + (lane & 15)) * UST + ko);
                                const bf16x8 bh = *(const LAS bf16x8*)(Whi + (ct * 16 + (lane & 15)) * UST + ko), bl = *(const LAS bf16x8*)(Wlo + (ct * 16 + (lane & 15)) * UST + ko);
                                acc[i] = __builtin_amdgcn_mfma_f32_16x16x32_bf16(ah, bh, acc[i], 0, 0, 0);
                                acc[i] = __builtin_amdgcn_mfma_f32_16x16x32_bf16(al, bh, acc[i], 0, 0, 0);
                                acc[i] = __builtin_amdgcn_mfma_f32_16x16x32_bf16(ah, bl, acc[i], 0, 0, 0); } } }
                  }
                }
#pragma unroll
                for (int i = 0; i < 3; ++i) { const int tile = wave + 8 * i;
                    if (tile < 20) { const int tt = tile / 5, ct = tile - tt * 5;
#pragma unroll
                        for (int r = 0; r < 4; ++r) LG[(tt * 16 + (lane >> 4) * 4 + r) * 80 + ct * 16 + (lane & 15)] = acc[i][r]; } }
                __syncthreads();
                int e0 = 0, e1 = 0; unsigned lr0 = 0, lr1 = 0;
                if (tid < 64) {
                    const LAS float* lg = LG + tid * 80; float gl[8]; float gm = -3.0e38f; int gi = 0;
#pragma unroll
                    for (int j = 0; j < 8; ++j) { gl[j] = lg[j] + b_rg[j]; if (gl[j] > gm) { gm = gl[j]; gi = j; } }
                    float gs = 0.f;
#pragma unroll
                    for (int j = 0; j < 8; ++j) gs += __expf(gl[j] - gm);
                    const float gp = 1.0f / gs;
                    float el[8]; float m0 = -3.0e38f, m1 = -3.0e38f; int i0 = 0, i1 = 0;
#pragma unroll
                    for (int j = 0; j < 8; ++j) { el[j] = lg[8 + gi * 8 + j] + b_re[gi * 8 + j]; }
#pragma unroll
                    for (int j = 0; j < 8; ++j) { if (el[j] > m0) { m1 = m0; i1 = i0; m0 = el[j]; i0 = j; } else if (el[j] > m1) { m1 = el[j]; i1 = j; } }
                    const float x1 = __expf(m1 - m0), den = 1.0f / (1.0f + x1);
                    e0 = gi * 8 + i0; e1 = gi * 8 + i1;
                    tok_e[(t0 + tid) * 2] = e0; tok_e[(t0 + tid) * 2 + 1] = e1;
                    tok_w[(t0 + tid) * 2] = gp * den; tok_w[(t0 + tid) * 2 + 1] = gp * x1 * den;
                    lr0 = __hip_atomic_fetch_add(LCNT + e0, 1u, __ATOMIC_RELAXED, __HIP_MEMORY_SCOPE_WORKGROUP);
                    lr1 = __hip_atomic_fetch_add(LCNT + e1, 1u, __ATOMIC_RELAXED, __HIP_MEMORY_SCOPE_WORKGROUP);
                }
                __syncthreads();
                if (tid < 64) { const unsigned c = LCNT[tid]; LBASE[tid] = c ? __hip_atomic_fetch_add(ecnt + tid, c, RLX_AGENT) : 0u; }
                __syncthreads();
                if (tid < 64) { tok_rank[(t0 + tid) * 2] = (int)(LBASE[e0] + lr0); tok_rank[(t0 + tid) * 2 + 1] = (int)(LBASE[e1] + lr1); }
            }
            __syncthreads();
        }
    }
    SEAM(6);

    if (IN(7)) {
        LAS unsigned* PST = (LAS unsigned*)(ldsl);
        if (tid < 64) {
            const unsigned pad = ((ld_ctl(ecnt + tid) + 255u) >> 8) << 8; unsigned incl = pad;
#pragma unroll
            for (int o = 1; o < 64; o <<= 1) { const unsigned n = __shfl_up(incl, o); if (lane >= o) incl += n; }
            PST[tid] = incl - pad; if (tid == 63) PST[NEXP] = incl;
            if (bx == 0) { const unsigned first = (incl - pad) >> 8, n = pad >> 8; for (unsigned q = 0; q < n; ++q) tile_tab[16 + first + q] = (unsigned)tid; if (tid == 63) tile_tab[0] = incl >> 8; } }
        __syncthreads();
        for (int sl = bx * 512 + tid; sl < T * 2; sl += G * 512) { const int row = (int)PST[tok_e[sl]] + tok_rank[sl]; tok_row[sl] = row; row_tok[row] = sl >> 1; }
        __syncthreads();
    }
    SEAM(7);

    if (IN(8)) {
        const int ntiles = (int)ld_ctl(tile_tab);
        LAS unsigned* ltab = (LAS unsigned*)(ldsl + LTAB_OFF);
        if (tid < 256) ltab[tid] = tid < ntiles ? ld_ctl(tile_tab + 16 + tid) : 0u;
        __syncthreads();
        pg8::Shape g{1024, 1024, 1024};
        pg8::SchedMoe S{(const char*)U2, (const char*)WguT, (const char*)WguT, 64, ltab, row_tok, ntiles, 4, G, bx, (size_t)0, (size_t)1024 * 2048, (size_t)256 * 2048};
        pg8::EpiGU E{HDN, 1.0f / WGU_PRESCALE};
        pg8::gemm_phase<pg8::EpiGU, pg8::SchedMoe, true, true, true>(ldsl, g, S, E);
        { const int vbx = (G % 8 == 0) ? (bx % 8) * (G / 8) + bx / 8 : bx;
          const int rem = (ntiles * 4) % G; const bool all = rem == 0; const int nconv = all ? G : G - rem, crank = all ? vbx : vbx - rem;
            if (all || vbx >= rem) { __syncthreads(); EXPERT_CONVERT_S(2 * CONV_I_G + WD_SPLIT * 256, 2 * CONV_I_G + NEXP * 256, crank * 8 + wave, nconv * 8); __syncthreads(); } }
    }
    SEAM(8);

    if (IN(9)) {
        const int ntiles = (int)ld_ctl(tile_tab);
        LAS unsigned* ltab = (LAS unsigned*)(ldsl + LTAB_OFF);
        if (tid < 256) ltab[tid] = tid < ntiles ? ld_ctl(tile_tab + 16 + tid) : 0u;
        __syncthreads();
        pg8::Shape g{256, 256, 256};
        pg8::SchedMoe S{(const char*)HDN, (const char*)WdA, (const char*)WdB, WD_SPLIT, ltab, row_tok, ntiles, 8, G, bx, (size_t)256 * 512, (size_t)2048 * 512, (size_t)256 * 512};
        pg8::EpiPlain E{(unsigned char*)YM, 2048, 1.0f / WGU_PRESCALE};
        pg8::gemm_phase<pg8::EpiPlain, pg8::SchedMoe, true, false, true>(ldsl, g, S, E);
    }
    SEAM(9);

    if (IN(10)) {
        { v4u hq[2][4]; v2u ya[2][4], yb[2][4]; float w0[2], w1[2]; int rn0 = 0, rn1 = 0; float wn0 = 0.f, wn1 = 0.f;
#define P10_IDX(m_) do { rn0 = tok_row[(m_) * 2]; rn1 = tok_row[(m_) * 2 + 1]; wn0 = tok_w[(m_) * 2]; wn1 = tok_w[(m_) * 2 + 1]; } while (0)
#define P10_LOAD(S_, m_) do { const int r0_ = rn0, r1_ = rn1; w0[S_] = wn0; w1[S_] = wn1; \
            const v4u* hr_ = (const v4u*)(Hf + (size_t)(m_) * DM); const v2u* y0_ = (const v2u*)((const unsigned char*)YM + (size_t)r0_ * DM); const v2u* y1_ = (const v2u*)((const unsigned char*)YM + (size_t)r1_ * DM); \
            _Pragma("unroll") for (int j_ = 0; j_ < 4; ++j_) { const int ci_ = j_ * 64 + lane; hq[S_][j_] = __builtin_nontemporal_load(hr_ + ci_); ya[S_][j_] = __builtin_nontemporal_load(y0_ + ci_); yb[S_][j_] = __builtin_nontemporal_load(y1_ + ci_); } } while (0)
          int m = gw; if (m < T) { P10_IDX(m); P10_LOAD(0, m); if (m + NGW < T) P10_IDX(m + NGW); }
          for (int it = 0; m < T; m += NGW, ++it) {
#pragma unroll
            for (int par = 0; par < 2; ++par) { if ((it & 1) == par) {
              if (m + NGW < T) { P10_LOAD(par ^ 1, m + NGW); if (m + 2 * NGW < T) P10_IDX(m + 2 * NGW); }
              f32x4 v[8]; float sacc = 0.f;
#pragma unroll
              for (int j = 0; j < 4; ++j) { const v2u a = ya[par][j], bq = yb[par][j]; const v4u hh = hq[par][j];
                  const f32x4 ha = (f32x4){bflo(hh.x), bfhi(hh.x), bflo(hh.y), bfhi(hh.y)}, hb = (f32x4){bflo(hh.z), bfhi(hh.z), bflo(hh.w), bfhi(hh.w)};
                  v[2 * j] = ha + fp8x4_to_f32(a.x) * w0[par] + fp8x4_to_f32(bq.x) * w1[par];
                  v[2 * j + 1] = hb + fp8x4_to_f32(a.y) * w0[par] + fp8x4_to_f32(bq.y) * w1[par]; }
#pragma unroll
              for (int j = 0; j < 8; ++j) sacc += (v[j][0] * v[j][0] + v[j][1] * v[j][1]) + (v[j][2] * v[j][2] + v[j][3] * v[j][3]);
              const float rstd = 1.0f / sqrtf(wave_sum(sacc) * (1.f / DM) + EPS);
              f32x4* op = (f32x4*)(args.out + (size_t)m * DM); const f32x4* wp = (const f32x4*)norm_final_w;
#pragma unroll
              for (int j = 0; j < 4; ++j) { const int ci = j * 64 + lane; op[ci * 2] = v[2 * j] * rstd * wp[ci * 2]; op[ci * 2 + 1] = v[2 * j + 1] * rstd * wp[ci * 2 + 1]; }
            } }
          }
#undef P10_LOAD
#undef P10_IDX
        }
    }
#undef IN
#undef SEAM
}

extern "C" void kernel_launch(void* const* d_in, const int* in_sizes, int n_in, void* d_out, int out_size, void* d_ws, size_t ws_size, hipStream_t stream) {
    static int grid = 0;
    if (grid == 0) {
        if (n_in != 22 || out_size != T * DM || ws_size < WS_END) { fprintf(stderr, "kernel_launch: unexpected shapes (n_in %d out %d ws %zu)\n", n_in, out_size, ws_size); grid = -1; return; }
        int dev = 0, cus = 0;
        if (hipGetDevice(&dev) != hipSuccess || hipDeviceGetAttribute(&cus, hipDeviceAttributeMultiprocessorCount, dev) != hipSuccess) { grid = -1; return; }
        if (hipFuncSetAttribute((const void*)mega_fwd, hipFuncAttributeMaxDynamicSharedMemorySize, LDS_BYTES) != hipSuccess) { fprintf(stderr, "kernel_launch: hipFuncSetAttribute failed\n"); grid = -1; return; }
        int per_cu = 0;
        if (hipOccupancyMaxActiveBlocksPerMultiprocessor(&per_cu, (const void*)mega_fwd, 512, LDS_BYTES) != hipSuccess || per_cu < 1) fprintf(stderr, "kernel_launch: occupancy query says %d\n", per_cu);
        (void)hipGetLastError();
        grid = cus > 0 ? cus : 256;
    }
    if (grid < 0) return;
    (void)hipMemsetAsync((char*)d_ws + WS_CTL, 0, CTL_ZERO_BYTES, stream);
    Args a{};
    for (int i = 0; i < 22; ++i) a.in[i] = (const float*)d_in[i];
    a.out = (float*)d_out; a.ws = (unsigned char*)d_ws; a.sub = 15;
#if N_LAUNCH_MODE == 1
    a.ph_lo = 0; a.ph_hi = NPHASE;
    hipLaunchKernelGGL(mega_fwd, dim3(grid), dim3(512), LDS_BYTES, stream, a);
#else
    for (int p = 0; p < NPHASE; ++p) { a.ph_lo = p; a.ph_hi = p + 1; a.sub = 15; hipLaunchKernelGGL(mega_fwd, dim3(grid), dim3(512), LDS_BYTES, stream, a);
#ifdef PROBE_PH
        if (p == PROBE_PH) { a.sub = PROBE_SUB; for (int r = 0; r < PROBE_REP; ++r) hipLaunchKernelGGL(mega_fwd, dim3(grid), dim3(512), LDS_BYTES, stream, a); }
#endif
    }
#endif
}
```

```cpp
#include <hip/hip_runtime.h>
#include <cstdio>
#include <cstdint>

#ifndef N_LAUNCH_MODE
#define N_LAUNCH_MODE 1
#endif

#define GAS __attribute__((address_space(1)))
#define LAS __attribute__((address_space(3)))
typedef unsigned short bf16;
typedef unsigned v4u __attribute__((ext_vector_type(4)));
typedef unsigned v2u __attribute__((ext_vector_type(2)));
typedef float f32x4 __attribute__((ext_vector_type(4)));
typedef float f32x16 __attribute__((ext_vector_type(16)));
typedef short bf16x8 __attribute__((ext_vector_type(8)));
typedef short s16x4 __attribute__((ext_vector_type(4)));
#define RLX_AGENT __ATOMIC_RELAXED, __HIP_MEMORY_SCOPE_AGENT
#define LDS_WAIT() asm volatile("s_waitcnt lgkmcnt(0)" ::: "memory")
#define VM_WAIT() asm volatile("s_waitcnt vmcnt(0)" ::: "memory")
#define LDS_BARRIER() do { asm volatile("s_waitcnt lgkmcnt(0)" ::: "memory"); __builtin_amdgcn_s_barrier(); asm volatile("" ::: "memory"); } while (0)

constexpr int T = 16384, DM = 2048, SEQ = 4096, NB = 4;
constexpr int NPROJ = 15408, NPROJ_P = 15360, WIN_ROWS = 15408;
constexpr int SSD_H = 32, SSD_P = 64, SSD_N = 128, SSD_G = 4, CONVD = 3072;
constexpr int FOX_H = 16;
constexpr int NEXP = 64, DEXP = 512, MAXROWS = 49152;
constexpr float EPS = 1e-6f;
constexpr int SRC_Z = 0, SRC_XBC = 2048, SRC_DT = 5120, SRC_QKV = 5152, SRC_F = 11296, SRC_GATE = 11312;
constexpr int DST_Z = 0, DST_XBC = 2048, DST_QKV = 5120, DST_GATE = 11264, DST_SMALL = 15360;

constexpr size_t MiB = 1u << 20;
constexpr size_t WS_CTL = 0, CTL_ZERO_BYTES = 1 * MiB;
constexpr size_t WS_TAB = 1 * MiB;
constexpr size_t WS_DT = 2 * MiB;
constexpr size_t WS_CUM = 4 * MiB;
constexpr size_t WS_WR = 11 * MiB;
constexpr size_t WS_WAB = 12 * MiB;
constexpr size_t WS_WO = 28 * MiB;
constexpr size_t WS_Q = 36 * MiB, WS_K = 100 * MiB, WS_V = 164 * MiB;
constexpr size_t WS_H = 36 * MiB;
constexpr size_t ARENA = 228 * MiB;
constexpr size_t WS_WIN = ARENA;
constexpr size_t WS_XN = 289 * MiB;
constexpr size_t WS_XBC = 353 * MiB;
constexpr size_t WS_Z = 449 * MiB;
constexpr size_t WS_G = 513 * MiB;
constexpr size_t WS_XC = 641 * MiB;
constexpr size_t WS_AB = 289 * MiB;
constexpr size_t WS_MIX = 641 * MiB;
constexpr size_t WS_WGU = 737 * MiB;
constexpr size_t WS_WDA = 228 * MiB;
constexpr size_t WS_WDB = 289 * MiB;
constexpr int WD_SPLIT = 30;
constexpr size_t WS_U2 = 612 * MiB;
constexpr size_t WS_HDN = 676 * MiB;
constexpr size_t WS_YM = 737 * MiB;
constexpr size_t WS_XN8 = 870 * MiB;
constexpr size_t WS_WQKV8 = 902 * MiB;
constexpr float XN_SCALE = 16.f;
constexpr size_t WS_WB8 = 865 * MiB;
constexpr size_t WS_PART = 870 * MiB;
constexpr size_t WS_YF8 = 934 * MiB;
constexpr float YF_SCALE = 32.f;
constexpr size_t WS_SS = 993 * MiB;
constexpr size_t WS_DTF = 997 * MiB;
constexpr size_t WS_END = 1005 * MiB;
constexpr int CW_CNT = 64;
constexpr int CW_BAR = 4096;
constexpr int CW_AQ = 512, CW_CQ = 1536, CW_QM = 8192, CW_KM = 9216;
constexpr size_t TAB_E = 0, TAB_W = 128 * 1024, TAB_RANK = 256 * 1024, TAB_ROW = 384 * 1024, TAB_TILE = 512 * 1024, TAB_ROWTOK = 768 * 1024;

constexpr int RING_BYTES = 131072;
constexpr int LDSCTL_OFF = 153600, MISC_OFF = LDSCTL_OFF + 320;
constexpr int LTAB_OFF = 147456;
constexpr int LDS_BYTES = 155648;

__device__ __forceinline__ unsigned f2bf(float f) { unsigned u = __builtin_bit_cast(unsigned, f); return (u + 0x7fffu + ((u >> 16) & 1u)) >> 16; }
__device__ __forceinline__ unsigned pk2(float lo, float hi) { return f2bf(lo) | (f2bf(hi) << 16); }
typedef float f32x2_t __attribute__((ext_vector_type(2))); typedef __bf16 bf16x2_t __attribute__((ext_vector_type(2)));
__device__ __forceinline__ unsigned cvt2(float lo, float hi) { f32x2_t v = {lo, hi}; bf16x2_t b = __builtin_convertvector(v, bf16x2_t); return __builtin_bit_cast(unsigned, b); }
__device__ __forceinline__ unsigned cvt_fp8x2(float a, float b, unsigned old, bool hi) {
    a = __builtin_fminf(__builtin_fmaxf(a, -448.f), 448.f); b = __builtin_fminf(__builtin_fmaxf(b, -448.f), 448.f);
    return hi ? (unsigned)__builtin_amdgcn_cvt_pk_fp8_f32(a, b, (int)old, true) : (unsigned)__builtin_amdgcn_cvt_pk_fp8_f32(a, b, (int)old, false); }
typedef float f32x2v_t __attribute__((ext_vector_type(2)));
__device__ __forceinline__ f32x4 fp8x4_to_f32(unsigned w) { const f32x2v_t lo = __builtin_amdgcn_cvt_pk_f32_fp8((int)w, false), hi = __builtin_amdgcn_cvt_pk_f32_fp8((int)w, true); return (f32x4){lo[0], lo[1], hi[0], hi[1]}; }
__device__ __forceinline__ unsigned cvt_fp8x4(float a, float b, float c, float d) { unsigned w = cvt_fp8x2(a, b, 0u, false); return cvt_fp8x2(c, d, w, true); }
__device__ __forceinline__ float bf2f(unsigned b) { return __uint_as_float(b << 16); }
__device__ __forceinline__ float bflo(unsigned w) { return __uint_as_float(w << 16); }
__device__ __forceinline__ float bfhi(unsigned w) { return __uint_as_float(w & 0xffff0000u); }
__device__ __forceinline__ float wave_sum(float v) {
#pragma unroll
    for (int o = 1; o < 64; o <<= 1) v += __shfl_xor(v, o);
    return v;
}
#define DPP_ADD(v, ctrl, rmask, bctl) ((v) + __builtin_bit_cast(float, __builtin_amdgcn_update_dpp(0, __builtin_bit_cast(int, (v)), (ctrl), (rmask), 0xF, (bctl))))
__device__ __forceinline__ float row16_sum(float v) {
    v = DPP_ADD(v, 0xB1, 0xF, true);
    v = DPP_ADD(v, 0x4E, 0xF, true);
    v = DPP_ADD(v, 0x141, 0xF, true);
    v = DPP_ADD(v, 0x140, 0xF, true);
    return v;
}
__device__ __forceinline__ float wave_incl_scan(float v) {
    v = DPP_ADD(v, 0x111, 0xF, false);
    v = DPP_ADD(v, 0x112, 0xF, false);
    v = DPP_ADD(v, 0x114, 0xF, false);
    v = DPP_ADD(v, 0x118, 0xF, false);
    v = DPP_ADD(v, 0x142, 0xA, false);
    v = DPP_ADD(v, 0x143, 0xC, false);
    return v;
}
__device__ __forceinline__ float sigmoidf_(float x) { return __builtin_amdgcn_rcpf(1.f + __expf(-x)); }
__device__ __forceinline__ float siluf_(float x) { return x * sigmoidf_(x); }
__device__ __forceinline__ unsigned ld_ctl(const unsigned* p) { return __hip_atomic_load(p, RLX_AGENT); }

namespace pg8 {
#define PG8_LAS __attribute__((address_space(3)))
constexpr int BM = 256, BK = 64, HALF = 128, HTB = HALF * BK * 2, STAGE_BYTES = 8 * HTB, NXCD = 8, WGM = 2;
__host__ __device__ __forceinline__ int lds_byte(int r, int c) { const int st = (r >> 4) * 2 + (c >> 5), rr = r & 15, cc = c & 31, ob = rr * 64 + cc * 2; return st * 1024 + (ob ^ (((ob >> 9) & 1) << 5)); }
__host__ __device__ __forceinline__ void stage_rc(int b, int& R, int& C) { const int st = b / 1024, sb = b % 1024, swz = sb ^ (((sb >> 9) & 1) << 5); R = (st >> 1) * 16 + swz / 64; C = (st & 1) * 32 + (swz % 64) / 2; }
__host__ __device__ __forceinline__ int perm32(int rho) { const int n = rho >> 4, i = rho & 15; return 8 * (i >> 2) + 4 * n + (i & 3); }
struct Unit { const char* A; const char* B; const int* rows; int pm, pn, aux; };
struct Shape { int K, lda, ldb; };
__device__ __forceinline__ void tile_of(int L, int nM, int nN, int& pm, int& pn) {
    const int nwg = nM * nN; int wgid = L; { const int q = nwg / NXCD, r = nwg % NXCD, xcd = wgid % NXCD, off = wgid / NXCD; wgid = (xcd < r ? xcd * (q + 1) : r * (q + 1) + (xcd - r) * q) + off; }
    const int nig = WGM * nN, gid = wgid / nig, fm = gid * WGM, gsz = (nM - fm) < WGM ? (nM - fm) : WGM;
    pm = fm + ((wgid % nig) % gsz); pn = (wgid % nig) / gsz;
}
__device__ __forceinline__ unsigned cvt_pk_bf16(float lo, float hi) { unsigned r; asm volatile("v_cvt_pk_bf16_f32 %0, %1, %2" : "=v"(r) : "v"(lo), "v"(hi)); return r; }

template <class Epi, class Sched, bool ALIGN_EPI, bool GATHER = false, bool FP8 = false>
__device__ __forceinline__ void gemm_phase(PG8_LAS unsigned char* lds, const Shape g, const Sched& S, const Epi& E) {
    const int tid = threadIdx.x, wid = __builtin_amdgcn_readfirstlane(tid >> 6), lane = tid & 63, wr = wid >> 2, wc = wid & 3, fr = lane & 15, fq = lane >> 4;
    const int K = g.K, nt = K / BK;
    unsigned voffA[2], voffB[2];
#pragma unroll
    for (int i = 0; i < 2; ++i) { int R, C; stage_rc(tid * 16 + i * 8192, R, C); const int Rb = Epi::PERM ? ((R & ~31) + perm32(R & 31)) : R;
        voffA[i] = (unsigned)(R * g.lda + C) * 2u; voffB[i] = (unsigned)(Rb * g.ldb + C) * 2u; }
    const size_t kstep = (size_t)(BK * 2);
    const size_t hstepA = (size_t)HALF * g.lda * 2, hstepB = (size_t)HALF * g.ldb * 2;
    const unsigned ldsw = (unsigned)wid * 1024u;
    const int aoff = lds_byte(wr * 64 + fr, fq * 8), boff = lds_byte(wc * 32 + fr, fq * 8);
#define PG8_SA(b, h) (((b) * 2 + (h)) * HTB)
#define PG8_SB(b, h) ((4 + (b) * 2 + (h)) * HTB)
#define PG8_STAGE(bufoff, gbase, voff) do { _Pragma("unroll") for (int _i = 0; _i < 2; ++_i) \
        __builtin_amdgcn_global_load_lds((const unsigned*)((const char*)(gbase) + (voff)[_i]), (PG8_LAS unsigned*)(lds + (bufoff) + ldsw + _i * 8192), 16, 0, 0); } while (0)
#define PG8_STAGE_A(bufoff, kptr, hf, vv) do { if constexpr (GATHER) { PG8_STAGE(bufoff, kptr, (vv)[hf]); } else { PG8_STAGE(bufoff, (kptr) + (hf) * hstepA, voffA); } } while (0)
#define PG8_GATHER_STORE(par, rowsp) do { unsigned d_[2][2]; _Pragma("unroll") for (int hf_ = 0; hf_ < 2; ++hf_) _Pragma("unroll") for (int i_ = 0; i_ < 2; ++i_) { int R_, C_; stage_rc(tid * 16 + i_ * 8192, R_, C_); \
        int tk_ = (rowsp)[hf_ * HALF + R_]; tk_ = tk_ < 0 ? 0 : tk_; d_[hf_][i_] = (unsigned)tk_ * (unsigned)(g.lda * 2) + (unsigned)(C_ * 2); } \
        gslot[(par) * 512] = (v4u){d_[0][0], d_[0][1], d_[1][0], d_[1][1]}; } while (0)
#define PG8_LDA(dst, b, h) do { _Pragma("unroll") for (int m = 0; m < 4; ++m) _Pragma("unroll") for (int k = 0; k < 2; ++k) dst[m][k] = *(const PG8_LAS bf16x8*)(lds + PG8_SA(b, h) + aoff + m * 2048 + k * 1024); } while (0)
#define PG8_LDB(dst, b, h) do { _Pragma("unroll") for (int n = 0; n < 2; ++n) _Pragma("unroll") for (int k = 0; k < 2; ++k) dst[n][k] = *(const PG8_LAS bf16x8*)(lds + PG8_SB(b, h) + boff + n * 2048 + k * 1024); } while (0)
#define PG8_MMA(ai, bj, At, Bt) do { __builtin_amdgcn_s_setprio(1); _Pragma("unroll") for (int m = 0; m < 4; ++m) _Pragma("unroll") for (int n = 0; n < 2; ++n) { \
        if constexpr (FP8) { typedef int v8i_ __attribute__((ext_vector_type(8))); typedef int v4i_ __attribute__((ext_vector_type(4))); \
            const v4i_ b0_ = __builtin_bit_cast(v4i_, Bt[n][0]), b1_ = __builtin_bit_cast(v4i_, Bt[n][1]), a0_ = __builtin_bit_cast(v4i_, At[m][0]), a1_ = __builtin_bit_cast(v4i_, At[m][1]); \
            const v8i_ bb_ = {b0_[0], b0_[1], b0_[2], b0_[3], b1_[0], b1_[1], b1_[2], b1_[3]}, aa_ = {a0_[0], a0_[1], a0_[2], a0_[3], a1_[0], a1_[1], a1_[2], a1_[3]}; \
              \
            asm volatile("s_nop 1\n\tv_mfma_scale_f32_16x16x128_f8f6f4 %0, %1, %2, %0, %3, %3 op_sel_hi:[0,0,0]" : "+v"(acc[ai][bj][m][n]) : "v"(bb_), "v"(aa_), "v"(0x7F7F7F7F)); } \
        else { _Pragma("unroll") for (int k = 0; k < 2; ++k) acc[ai][bj][m][n] = __builtin_amdgcn_mfma_f32_16x16x32_bf16(Bt[n][k], At[m][k], acc[ai][bj][m][n], 0, 0, 0); } } \
        __builtin_amdgcn_s_setprio(0); } while (0)
#define PG8_WAIT_V(n) asm volatile("s_waitcnt vmcnt(" #n ")" ::: "memory")
#define PG8_WAIT_L(n) asm volatile("s_waitcnt lgkmcnt(" #n ")" ::: "memory")
#define PG8_BAR __builtin_amdgcn_s_barrier()
#define PG8_SCHED __builtin_amdgcn_sched_barrier(0)
    Unit cur, nxt; int ui = 0;
    if (!S.next(0, cur)) return;
    f32x4 acc[2][2][4][2];
    bf16x8 At[4][2], B0[2][2], B1[2][2];
    const char* cA = cur.A; const char* cB = cur.B;
    PG8_LAS v4u* gslot = (PG8_LAS v4u*)(lds + STAGE_BYTES) + tid;
    unsigned vA_c[2][2] = {{0u, 0u}, {0u, 0u}};
    if constexpr (GATHER) { PG8_GATHER_STORE(0, cur.rows); const v4u v0_ = gslot[0]; vA_c[0][0] = v0_.x; vA_c[0][1] = v0_.y; vA_c[1][0] = v0_.z; vA_c[1][1] = v0_.w; }
    PG8_STAGE(PG8_SB(0, 0), cB, voffB); PG8_STAGE(PG8_SB(0, 1), cB + hstepB, voffB); PG8_STAGE_A(PG8_SA(0, 0), cA, 0, vA_c); PG8_STAGE_A(PG8_SA(0, 1), cA, 1, vA_c);
    if (wr == 1) PG8_BAR;
    PG8_WAIT_V(2); PG8_BAR;
    PG8_STAGE(PG8_SB(1, 0), cB + kstep, voffB); PG8_STAGE_A(PG8_SA(1, 0), cA + kstep, 0, vA_c); PG8_STAGE(PG8_SB(1, 1), cB + hstepB + kstep, voffB);
    PG8_WAIT_V(6); PG8_BAR;
    float zf_ = 0.f; asm volatile("" : "+v"(zf_));
#pragma unroll
    for (int a = 0; a < 2; ++a)
#pragma unroll
        for (int b = 0; b < 2; ++b)
#pragma unroll
            for (int m = 0; m < 4; ++m)
#pragma unroll
                for (int n = 0; n < 2; ++n) acc[a][b][m][n] = (f32x4){zf_, zf_, zf_, zf_};
    for (;;) {
        const bool has_next = S.next(ui + 1, nxt);
        const char* nA = has_next ? nxt.A : cA; const char* nB = has_next ? nxt.B : cB;
        int gr_[2][2] = {{0, 0}, {0, 0}};
        if constexpr (GATHER) { const int* nrows_ = has_next ? nxt.rows : cur.rows;
#pragma unroll
            for (int hf_ = 0; hf_ < 2; ++hf_)
#pragma unroll
                for (int i_ = 0; i_ < 2; ++i_) { int R_, C_; stage_rc(tid * 16 + i_ * 8192, R_, C_); gr_[hf_][i_] = nrows_[hf_ * HALF + R_]; } }
        for (int t = 0; t < nt; t += 2) {
            const bool last = (t == nt - 2);
            unsigned vsel[2][2] = {{0u, 0u}, {0u, 0u}};
            if constexpr (GATHER) { const v4u vc_ = gslot[(ui & 1) * 512]; vA_c[1][0] = vc_.z; vA_c[1][1] = vc_.w;
                const v4u vn_ = gslot[((ui + (last ? 1 : 0)) & 1) * 512]; vsel[0][0] = vn_.x; vsel[0][1] = vn_.y; vsel[1][0] = vn_.z; vsel[1][1] = vn_.w; }
            const char* a1 = cA + (size_t)(t + 1) * kstep;
            const char* a2 = last ? nA : cA + (size_t)(t + 2) * kstep; const char* b2 = last ? nB : cB + (size_t)(t + 2) * kstep;
            const char* a3 = a2 + kstep; const char* b3 = b2 + kstep;
            PG8_LDB(B0, 0, 0); PG8_LDB(B1, 0, 1); PG8_SCHED; PG8_LDA(At, 0, 0); PG8_STAGE_A(PG8_SA(1, 1), a1, 1, vA_c);
            PG8_WAIT_V(8); PG8_WAIT_L(0); PG8_BAR; PG8_MMA(0, 0, At, B0); PG8_MMA(0, 1, At, B1); PG8_BAR; PG8_SCHED;
            PG8_LDA(At, 0, 1); PG8_STAGE(PG8_SB(0, 0), b2, voffB); PG8_STAGE(PG8_SB(0, 1), b2 + hstepB, voffB); PG8_STAGE_A(PG8_SA(0, 0), a2, 0, vsel);
            PG8_WAIT_V(8); PG8_WAIT_L(0); PG8_BAR; PG8_MMA(1, 0, At, B0); PG8_MMA(1, 1, At, B1); PG8_BAR; PG8_SCHED;
            PG8_LDB(B0, 1, 0); PG8_LDB(B1, 1, 1); PG8_SCHED; PG8_LDA(At, 1, 0); PG8_STAGE_A(PG8_SA(0, 1), a2, 1, vsel);
            PG8_WAIT_V(8); PG8_WAIT_L(0); PG8_BAR; PG8_MMA(0, 0, At, B0); PG8_MMA(0, 1, At, B1); PG8_BAR; PG8_SCHED;
            PG8_LDA(At, 1, 1); PG8_STAGE(PG8_SB(1, 0), b3, voffB); PG8_STAGE(PG8_SB(1, 1), b3 + hstepB, voffB); PG8_STAGE_A(PG8_SA(1, 0), a3, 0, vsel);
            PG8_WAIT_V(8); PG8_WAIT_L(0); PG8_BAR; PG8_MMA(1, 0, At, B0); PG8_MMA(1, 1, At, B1); PG8_BAR; PG8_SCHED;
            if constexpr (GATHER) { if (t == 0) { unsigned d_[2][2];
#pragma unroll
                for (int hf_ = 0; hf_ < 2; ++hf_)
#pragma unroll
                    for (int i_ = 0; i_ < 2; ++i_) { int R_, C_; stage_rc(tid * 16 + i_ * 8192, R_, C_); int tk_ = gr_[hf_][i_]; tk_ = tk_ < 0 ? 0 : tk_; d_[hf_][i_] = (unsigned)tk_ * (unsigned)(g.lda * 2) + (unsigned)(C_ * 2); }
                gslot[((ui + 1) & 1) * 512] = (v4u){d_[0][0], d_[0][1], d_[1][0], d_[1][1]}; } }
        }
        if constexpr (ALIGN_EPI) { if (wr == 0) PG8_BAR; }
        if constexpr (FP8) { asm volatile("s_nop 15\n\ts_nop 3"); }
        E(acc, cur, wr, wc, fr, fq);
        if (!has_next) break;
        if (!(Epi::KEEP && cur.aux == 0)) {
#pragma unroll
        for (int a = 0; a < 2; ++a)
#pragma unroll
            for (int b = 0; b < 2; ++b)
#pragma unroll
                for (int m = 0; m < 4; ++m)
#pragma unroll
                    for (int n = 0; n < 2; ++n) acc[a][b][m][n] = (f32x4){0.f, 0.f, 0.f, 0.f};
        }
        cur = nxt; cA = nA; cB = nB; ++ui;

        if constexpr (ALIGN_EPI) { if (wr == 1) PG8_BAR; }
    }
    PG8_WAIT_V(0);
    if constexpr (!ALIGN_EPI) { if (wr == 0) PG8_BAR; }
    PG8_BAR;
#undef PG8_SA
#undef PG8_SB
#undef PG8_STAGE
#undef PG8_STAGE_A
#undef PG8_GATHER_STORE
#undef PG8_LDA
#undef PG8_LDB
#undef PG8_MMA
#undef PG8_WAIT_V
#undef PG8_WAIT_L
#undef PG8_BAR
#undef PG8_SCHED
}

struct SchedPlain {
    const char* A; const char* Bt; int nM, nN, G, c; size_t astep, bstep;
    __device__ __forceinline__ bool next(int i, Unit& u) const {
        const long L = (long)i * G + c; if (L >= (long)nM * nN) return false;
        tile_of((int)L, nM, nN, u.pm, u.pn); u.aux = 0; u.rows = nullptr; u.A = A + (size_t)u.pm * astep; u.B = Bt + (size_t)u.pn * bstep; return true; }
};
struct SchedCols {
    const char* A; const char* Bt; int nM, nN, G, c; size_t astep, bstep; int pn0, gap_at, gap; bool bt_by_out;
    __device__ __forceinline__ bool next(int i, Unit& u) const {
        const long L = (long)i * G + c; if (L >= (long)nM * nN) return false;
        int pn_; tile_of((int)L, nM, nN, u.pm, pn_); u.pn = pn0 + pn_ + (pn_ >= gap_at ? gap : 0); u.aux = 0; u.rows = nullptr;
        u.A = A + (size_t)u.pm * astep; u.B = Bt + (size_t)(bt_by_out ? u.pn : pn_) * bstep; return true; }
};
struct SchedPair {
    const char* A; const char* Bt; int nM, nN, G, c; size_t astep, bstep, koff;
    __device__ __forceinline__ bool next(int i, Unit& u) const {
        const long L = (long)(i >> 1) * G + c; if (L >= (long)nM * nN) return false;
        tile_of((int)L, nM, nN, u.pm, u.pn); u.aux = i & 1; u.rows = nullptr; u.A = A + (size_t)u.pm * astep + (size_t)u.aux * koff; u.B = Bt + (size_t)u.pn * bstep + (size_t)u.aux * koff; return true; }
};
struct SchedMoe {
    const char* A; const char* Bt; const char* Bt2; int esplit; const PG8_LAS unsigned* tile_tab; const int* row_tab; int ntiles, nN, G, c; size_t astep, bstep_e, bstep_n;
    __device__ __forceinline__ bool next(int i, Unit& u) const {
        const int vc = (G % 8 == 0) ? (c % 8) * (G / 8) + c / 8 : c;
        const long L = (long)i * G + vc; if (L >= (long)ntiles * nN) return false;
        const int rt = (int)(L / nN), pn = (int)(L % nN); const int e = (int)tile_tab[rt];
        u.pm = rt; u.pn = pn; u.aux = e; u.rows = row_tab + rt * 256; u.A = A + (size_t)rt * astep; u.B = (e < esplit ? Bt + (size_t)e * bstep_e : Bt2 + (size_t)(e - esplit) * bstep_e) + (size_t)pn * bstep_n; return true; }
};

struct EpiProj {
    static constexpr bool PERM = true, KEEP = false;
    bf16 *Z, *XBC, *Q, *K, *V, *G; PG8_LAS float* nsc; unsigned *qmax, *kmax; float osc;
    __device__ __forceinline__ void operator()(f32x4 (&acc)[2][2][4][2], const Unit& u, int wr, int wc, int fr, int fq) const {
        const int row0 = u.pm * BM + wr * 64 + fr; const int pn = u.pn;
        if (pn >= 20 && pn < 36) {
#pragma unroll
            for (int ai = 0; ai < 2; ++ai)
#pragma unroll
                for (int m = 0; m < 4; ++m)
#pragma unroll
                    for (int bj = 0; bj < 2; ++bj) { const f32x4 v0 = acc[ai][bj][m][0], v1 = acc[ai][bj][m][1];
                        float s = ((v0[0] * v0[0] + v0[1] * v0[1]) + (v0[2] * v0[2] + v0[3] * v0[3])) + ((v1[0] * v1[0] + v1[1] * v1[1]) + (v1[2] * v1[2] + v1[3] * v1[3])); s *= osc * osc;
                        s += __shfl_xor(s, 16); s += __shfl_xor(s, 32);
                        if (fq == 0) nsc[((ai * HALF + wr * 64 + m * 16 + fr) * 2 + bj) * 4 + wc] = s; }
            asm volatile("s_waitcnt lgkmcnt(0)" ::: "memory"); __builtin_amdgcn_s_barrier();
            { const int t_ = threadIdx.x; const f32x4 p = *(const PG8_LAS f32x4*)(nsc + t_ * 4);
              float s = (p[0] + p[1]) + (p[2] + p[3]);
#pragma unroll
              for (int o = 2; o < 64; o <<= 1) s = fmaxf(s, __shfl_xor(s, o));
              if ((t_ & 63) < 2) { unsigned* dst = (pn < 28 ? qmax : kmax) + ((u.pm >> 4) * 16 + ((pn - 20) & 7) * 2 + (t_ & 1)) * 16 + (u.pm & 15);
                  __hip_atomic_fetch_max(dst, __float_as_uint(s * 1.008f), __ATOMIC_RELAXED, __HIP_MEMORY_SCOPE_AGENT); } }
        }
        bf16* base; int ldc, ct;
        if (pn < 8) { base = Z; ldc = 2048; ct = pn; }
        else if (pn < 20) { base = XBC; ldc = 3072; ct = pn - 8; }
        else if (pn < 28) { base = Q; ldc = 2048; ct = pn - 20; }
        else if (pn < 36) { base = K; ldc = 2048; ct = pn - 28; }
        else if (pn < 44) { base = V; ldc = 2048; ct = pn - 36; }
        else { base = G; ldc = 4096; ct = pn - 44; }
        const int col0 = ct * BM + wc * 32 + 8 * fq;
#pragma unroll
        for (int ai = 0; ai < 2; ++ai)
#pragma unroll
            for (int m = 0; m < 4; ++m) { bf16* rowp = base + (size_t)(row0 + ai * HALF + m * 16) * ldc + col0;
#pragma unroll
                for (int bj = 0; bj < 2; ++bj) { const f32x4 v0 = acc[ai][bj][m][0] * osc, v1 = acc[ai][bj][m][1] * osc;
                    v4u w; w.x = cvt_pk_bf16(v0[0], v0[1]); w.y = cvt_pk_bf16(v0[2], v0[3]); w.z = cvt_pk_bf16(v1[0], v1[1]); w.w = cvt_pk_bf16(v1[2], v1[3]);
                    *(v4u*)(rowp + bj * HALF) = w; } }
    }
};
struct EpiMix {
    static constexpr bool PERM = true, KEEP = true;
    const bf16* G; const float* SS; bf16* MIX; PG8_LAS float* RL;
    __device__ __forceinline__ void operator()(f32x4 (&acc)[2][2][4][2], const Unit& u, int wr, int wc, int fr, int fq) const {
        const int row0 = u.pm * BM + wr * 64 + fr, col0 = u.pn * BM + wc * 32 + 8 * fq;
        if (u.aux == 0) {
            const int t = threadIdx.x, r = t >> 1, hf = t & 1; const f32x4* sp = (const f32x4*)(SS + (size_t)(u.pm * BM + r) * 32 + hf * 16); float s = 0.f;
#pragma unroll
            for (int q = 0; q < 4; ++q) { const f32x4 x = sp[q]; s += (x[0] + x[1]) + (x[2] + x[3]); }
            s += __shfl_xor(s, 1);
            if (hf == 0) RL[r] = 1.0f / sqrtf(s * (1.f / 2048.f) + EPS);
            asm volatile("s_waitcnt lgkmcnt(0)" ::: "memory"); __builtin_amdgcn_s_barrier(); asm volatile("" ::: "memory");
        }
#pragma unroll
        for (int ai = 0; ai < 2; ++ai)
#pragma unroll
            for (int m = 0; m < 4; ++m) { const int row = row0 + ai * HALF + m * 16;
                float rs = 1.f;
                if (u.aux == 0) rs = RL[wr * 64 + fr + ai * HALF + m * 16];
#pragma unroll
                for (int bj = 0; bj < 2; ++bj) { const int col = col0 + bj * HALF;
                    const v4u gf = *(const v4u*)(G + (size_t)row * 4096 + 2048 + col);
                    const float ef[8] = {__expf(-bflo(gf.x)), __expf(-bfhi(gf.x)), __expf(-bflo(gf.y)), __expf(-bfhi(gf.y)), __expf(-bflo(gf.z)), __expf(-bfhi(gf.z)), __expf(-bflo(gf.w)), __expf(-bfhi(gf.w))};
                    if (u.aux == 0) {
                        const v4u gs = *(const v4u*)(G + (size_t)row * 4096 + col);
                        const float sg[8] = {sigmoidf_(bflo(gs.x)), sigmoidf_(bfhi(gs.x)), sigmoidf_(bflo(gs.y)), sigmoidf_(bfhi(gs.y)), sigmoidf_(bflo(gs.z)), sigmoidf_(bfhi(gs.z)), sigmoidf_(bflo(gs.w)), sigmoidf_(bfhi(gs.w))};
#pragma unroll
                        for (int e = 0; e < 8; ++e) acc[ai][bj][m][e >> 2][e & 3] *= sg[e] * rs * (1.f + ef[e]);
                    } else {
                        float v[8];
#pragma unroll
                        for (int e = 0; e < 8; ++e) v[e] = acc[ai][bj][m][e >> 2][e & 3] * __builtin_amdgcn_rcpf(1.f + ef[e]);
                        v4u w; w.x = cvt_pk_bf16(v[0], v[1]); w.y = cvt_pk_bf16(v[2], v[3]); w.z = cvt_pk_bf16(v[4], v[5]); w.w = cvt_pk_bf16(v[6], v[7]);
                        *(v4u*)(MIX + (size_t)row * 2048 + col) = w; } } }
    }
};
struct EpiMixA {
    static constexpr bool PERM = true, KEEP = false;
    const bf16* G; const float* SS; bf16* P; PG8_LAS float* RL;
    __device__ __forceinline__ void operator()(f32x4 (&acc)[2][2][4][2], const Unit& u, int wr, int wc, int fr, int fq) const {
        const int row0 = u.pm * BM + wr * 64 + fr, col0 = u.pn * BM + wc * 32 + 8 * fq;
        { const int t = threadIdx.x, r = t >> 1, hf = t & 1; const f32x4* sp = (const f32x4*)(SS + (size_t)(u.pm * BM + r) * 32 + hf * 16); float s = 0.f;
#pragma unroll
          for (int q = 0; q < 4; ++q) { const f32x4 x = sp[q]; s += (x[0] + x[1]) + (x[2] + x[3]); }
          s += __shfl_xor(s, 1);
          asm volatile("s_waitcnt lgkmcnt(0)" ::: "memory"); __builtin_amdgcn_s_barrier();
          if (hf == 0) RL[r] = 1.0f / sqrtf(s * (1.f / 2048.f) + EPS);
          asm volatile("s_waitcnt lgkmcnt(0)" ::: "memory"); __builtin_amdgcn_s_barrier(); asm volatile("" ::: "memory"); }
#pragma unroll
        for (int ai = 0; ai < 2; ++ai)
#pragma unroll
            for (int m = 0; m < 4; ++m) { const int row = row0 + ai * HALF + m * 16; const float rs = RL[wr * 64 + fr + ai * HALF + m * 16];
#pragma unroll
                for (int bj = 0; bj < 2; ++bj) { const int col = col0 + bj * HALF;
                    const v4u gs = __builtin_nontemporal_load((const v4u*)(G + (size_t)row * 4096 + col));
                    const float sg[8] = {sigmoidf_(bflo(gs.x)), sigmoidf_(bfhi(gs.x)), sigmoidf_(bflo(gs.y)), sigmoidf_(bfhi(gs.y)), sigmoidf_(bflo(gs.z)), sigmoidf_(bfhi(gs.z)), sigmoidf_(bflo(gs.w)), sigmoidf_(bfhi(gs.w))};
                    float v[8];
#pragma unroll
                    for (int e = 0; e < 8; ++e) v[e] = acc[ai][bj][m][e >> 2][e & 3] * (sg[e] * rs);
                    v4u w; w.x = cvt_pk_bf16(v[0], v[1]); w.y = cvt_pk_bf16(v[2], v[3]); w.z = cvt_pk_bf16(v[4], v[5]); w.w = cvt_pk_bf16(v[6], v[7]);
                    *(v4u*)(P + (size_t)row * 2048 + col) = w; } }
    }
};
struct EpiMixB {
    static constexpr bool PERM = true, KEEP = false;
    const bf16* G; const bf16* P; bf16* MIX; float sc;
    __device__ __forceinline__ void operator()(f32x4 (&acc)[2][2][4][2], const Unit& u, int wr, int wc, int fr, int fq) const {
        const int row0 = u.pm * BM + wr * 64 + fr, col0 = u.pn * BM + wc * 32 + 8 * fq;
#pragma unroll
        for (int ai = 0; ai < 2; ++ai)
#pragma unroll
            for (int m = 0; m < 4; ++m) { const int row = row0 + ai * HALF + m * 16;
#pragma unroll
                for (int bj = 0; bj < 2; ++bj) { const int col = col0 + bj * HALF;
                    const v4u gf = __builtin_nontemporal_load((const v4u*)(G + (size_t)row * 4096 + 2048 + col));
                    const v4u pp = *(const v4u*)(P + (size_t)row * 2048 + col);
                    const float sg[8] = {sigmoidf_(bflo(gf.x)), sigmoidf_(bfhi(gf.x)), sigmoidf_(bflo(gf.y)), sigmoidf_(bfhi(gf.y)), sigmoidf_(bflo(gf.z)), sigmoidf_(bfhi(gf.z)), sigmoidf_(bflo(gf.w)), sigmoidf_(bfhi(gf.w))};
                    const float pv[8] = {bflo(pp.x), bfhi(pp.x), bflo(pp.y), bfhi(pp.y), bflo(pp.z), bfhi(pp.z), bflo(pp.w), bfhi(pp.w)};
                    float v[8];
#pragma unroll
                    for (int e = 0; e < 8; ++e) v[e] = pv[e] + acc[ai][bj][m][e >> 2][e & 3] * (sc * sg[e]);
                    v4u w; w.x = cvt_pk_bf16(v[0], v[1]); w.y = cvt_pk_bf16(v[2], v[3]); w.z = cvt_pk_bf16(v[4], v[5]); w.w = cvt_pk_bf16(v[6], v[7]);
                    *(v4u*)(MIX + (size_t)row * 2048 + col) = w; } }
    }
};
struct EpiRes {
    static constexpr bool PERM = true, KEEP = false;
    const float* X; bf16* H;
    __device__ __forceinline__ void operator()(f32x4 (&acc)[2][2][4][2], const Unit& u, int wr, int wc, int fr, int fq) const {
        const int row0 = u.pm * BM + wr * 64 + fr, col0 = u.pn * BM + wc * 32 + 8 * fq;
#pragma unroll
        for (int ai = 0; ai < 2; ++ai)
#pragma unroll
            for (int m = 0; m < 4; ++m) { const size_t off = (size_t)(row0 + ai * HALF + m * 16) * 2048 + col0;
#pragma unroll
                for (int bj = 0; bj < 2; ++bj) { const f32x4 x0 = __builtin_nontemporal_load((const f32x4*)(X + off + bj * HALF)), x1 = __builtin_nontemporal_load((const f32x4*)(X + off + bj * HALF + 4));
                    const f32x4 v0 = x0 + acc[ai][bj][m][0], v1 = x1 + acc[ai][bj][m][1];
                    v4u w; w.x = cvt_pk_bf16(v0[0], v0[1]); w.y = cvt_pk_bf16(v0[2], v0[3]); w.z = cvt_pk_bf16(v1[0], v1[1]); w.w = cvt_pk_bf16(v1[2], v1[3]);
                    *(v4u*)(H + off + bj * HALF) = w; } }
    }
};
struct EpiGU {
    static constexpr bool PERM = true, KEEP = false;
    bf16* HDN; float wsc;
    __device__ __forceinline__ void operator()(f32x4 (&acc)[2][2][4][2], const Unit& u, int wr, int wc, int fr, int fq) const {
        const int row0 = u.pm * BM + wr * 64 + fr, col0 = u.pn * HALF + wc * 32 + 8 * fq;
#pragma unroll
        for (int ai = 0; ai < 2; ++ai)
#pragma unroll
            for (int m = 0; m < 4; ++m) { float v[8];
#pragma unroll
                for (int e = 0; e < 8; ++e) { const float gt = acc[ai][0][m][e >> 2][e & 3] * wsc, up = acc[ai][1][m][e >> 2][e & 3] * wsc; v[e] = siluf_(gt) * up; }
                v2u w; w.x = cvt_fp8x4(v[0], v[1], v[2], v[3]); w.y = cvt_fp8x4(v[4], v[5], v[6], v[7]);
                *(v2u*)((unsigned char*)HDN + (size_t)(row0 + ai * HALF + m * 16) * 512 + col0) = w; }
    }
};
struct EpiPlain {
    static constexpr bool PERM = true, KEEP = false;
    unsigned char* O; int ldc; float sc;
    __device__ __forceinline__ void operator()(f32x4 (&acc)[2][2][4][2], const Unit& u, int wr, int wc, int fr, int fq) const {
        const int row0 = u.pm * BM + wr * 64 + fr, col0 = u.pn * BM + wc * 32 + 8 * fq;
#pragma unroll
        for (int ai = 0; ai < 2; ++ai)
#pragma unroll
            for (int m = 0; m < 4; ++m) { unsigned char* rowp = O + (size_t)(row0 + ai * HALF + m * 16) * ldc + col0;
#pragma unroll
                for (int bj = 0; bj < 2; ++bj) { const f32x4 v0 = acc[ai][bj][m][0] * sc, v1 = acc[ai][bj][m][1] * sc;
                    v2u w; w.x = cvt_fp8x4(v0[0], v0[1], v0[2], v0[3]); w.y = cvt_fp8x4(v1[0], v1[1], v1[2], v1[3]);
                    *(v2u*)(rowp + bj * HALF) = w; } }
    }
};
}

namespace att {
constexpr int D = 128, KP = 2048, OP = 4096;
constexpr float SCALE = 0.08838834764831845f;
constexpr int NW = 8, QBLK = 32, KVBLK = 64, QB = NW * QBLK;
constexpr int SHM_V = KVBLK * D * 2, SHM_K = KVBLK * D * 2;
constexpr int LDS_WS = 2 * SHM_V + 2 * SHM_K, LDS_BIAS = LDS_WS + NW * 64 * 4, LDS_BYTES = LDS_BIAS + SEQ * 16;
constexpr float THR = 8.f;
constexpr unsigned WBIG = 0x40000000u;
#define KSWZ(row, colB) ((row) * 256 + ((colB) ^ (((row) & 7) << 4)))
#define SBAR() __builtin_amdgcn_sched_barrier(0)
__device__ __forceinline__ int v_st(int k, int c) { const int kk = (k & ~0xC) | ((k & 4) << 1) | ((k & 8) >> 1); return ((kk >> 3) * 4 + (c >> 5)) * 512 + ((kk & 7) * 32 + (c & 31)) * 2; }
__device__ __forceinline__ int v_rd_base(int lane) { return ((lane & 3) << 3) | (((lane >> 2) & 3) << 6) | (((lane >> 4) & 1) << 5) | (((lane >> 5) & 1) << 8); }
constexpr int v_rd_off(int d0, int ks, int half) { return d0 * 512 + ks * 4096 + half * 2048; }
__device__ __forceinline__ int crow(int r, int hi) { return (r & 3) + 8 * (r >> 2) + 4 * hi; }
__device__ __forceinline__ unsigned cvtpk(float lo, float hi) { unsigned r; asm volatile("v_cvt_pk_bf16_f32 %0, %1, %2" : "=v"(r) : "v"(lo), "v"(hi)); return r; }
__device__ __forceinline__ bf16x8 load8(const bf16* p) { return *reinterpret_cast<const bf16x8*>(p); }
__device__ __forceinline__ void mask_tile(f32x16& p0, f32x16& p1, int dq, unsigned W) {
    const float NEG = -__builtin_inff();
#pragma unroll
    for (int r = 0; r < 16; ++r) {
        const int c = (r & 3) + 8 * (r >> 2);
        if ((unsigned)(dq - c) >= W) p0[r] = NEG;
        if ((unsigned)(dq - c - 32) >= W) p1[r] = NEG;
    }
}
__device__ __forceinline__ void partialSM(f32x16& p0, f32x16& p1, float& m_reg, float& mn, float& alpha) {
    float pmax = p0[0]; for (int r = 1; r < 16; ++r) pmax = fmaxf(pmax, p0[r]); for (int r = 0; r < 16; ++r) pmax = fmaxf(pmax, p1[r]);
    { auto rr = __builtin_amdgcn_permlane32_swap(__float_as_uint(pmax), __float_as_uint(pmax), false, false);
      pmax = fmaxf(__uint_as_float(rr[0]), __uint_as_float(rr[1])); }
    constexpr float C2 = 1.4426950408889634f * SCALE;
    if (__builtin_expect(__all((pmax - m_reg) * SCALE <= THR), 1)) { mn = m_reg; alpha = 1.f; }
    else { mn = fmaxf(m_reg, pmax); alpha = __builtin_amdgcn_exp2f((m_reg - mn) * C2); m_reg = mn; }
    const float mnL = -mn * C2;
    for (int r = 0; r < 16; ++r) p0[r] = fmaf(p0[r], C2, mnL); for (int r = 0; r < 16; ++r) p1[r] = fmaf(p1[r], C2, mnL);
    for (int r = 0; r < 16; ++r) p0[r] = __builtin_amdgcn_exp2f(p0[r]);
}
__device__ __forceinline__ void finishSM(f32x16& p0, f32x16& p1, float alpha, float& l_reg, bf16x8& pa0, bf16x8& pa1, bf16x8& pa2, bf16x8& pa3) {
    for (int r = 0; r < 16; ++r) p1[r] = __builtin_amdgcn_exp2f(p1[r]);
    float ps = 0; for (int r = 0; r < 16; ++r) ps += p0[r]; for (int r = 0; r < 16; ++r) ps += p1[r];
    { auto rr = __builtin_amdgcn_permlane32_swap(__float_as_uint(ps), __float_as_uint(ps), false, false);
      ps = __uint_as_float(rr[0]) + __uint_as_float(rr[1]); }
    l_reg = l_reg * alpha + ps;
#define PK4(P, B_, OUT) do { unsigned a0 = cvtpk(P[B_+0], P[B_+1]), a1 = cvtpk(P[B_+2], P[B_+3]);                          \
        unsigned b0 = cvtpk(P[B_+4], P[B_+5]), b1 = cvtpk(P[B_+6], P[B_+7]);                                             \
        auto r0 = __builtin_amdgcn_permlane32_swap(a0, b0, false, false); auto r1 = __builtin_amdgcn_permlane32_swap(a1, b1, false, false); \
        v4u w = {r0[0], r1[0], r0[1], r1[1]}; OUT = *reinterpret_cast<bf16x8*>(&w); } while (0)
    PK4(p0, 0, pa0); PK4(p0, 8, pa1); PK4(p1, 0, pa2); PK4(p1, 8, pa3);
#undef PK4
}
template <int KB>
__device__ __forceinline__ void qkt(f32x16& p0, f32x16& p1, const char* K_lds, int r32, int hi, const bf16x8* qr, const char* bt, const bf16x8 qones, const bool nobias = false) {
    if (nobias) {
#pragma unroll
        for (int r = 0; r < 16; ++r) { p0[r] = 0.f; p1[r] = 0.f; } }
    else { const v2u f0 = *(const v2u*)bt, f1 = *(const v2u*)(bt + 32 * 16);
        const v4u w0 = {f0.x, f0.y, 0u, 0u}, w1 = {f1.x, f1.y, 0u, 0u};
        const f32x16 z = {};
        p0 = __builtin_amdgcn_mfma_f32_32x32x16_bf16(__builtin_bit_cast(bf16x8, w0), qones, z, 0, 0, 0);
        p1 = __builtin_amdgcn_mfma_f32_32x32x16_bf16(__builtin_bit_cast(bf16x8, w1), qones, z, 0, 0, 0); }
    const char* kb[4];
#pragma unroll
    for (int dd = 0; dd < 4; ++dd) kb[dd] = K_lds + KB * SHM_K + KSWZ(r32, (dd * 16 + hi * 8) * 2);
#pragma unroll
    for (int d0 = 0; d0 < 8; ++d0) { const char* a = kb[d0 & 3] + (d0 >> 2) * 128;
        bf16x8 b0 = *reinterpret_cast<const bf16x8*>(a);
        bf16x8 b1 = *reinterpret_cast<const bf16x8*>(a + 32 * 256);
        p0 = __builtin_amdgcn_mfma_f32_32x32x16_bf16(b0, qr[d0], p0, 0, 0, 0);
        p1 = __builtin_amdgcn_mfma_f32_32x32x16_bf16(b1, qr[d0], p1, 0, 0, 0); }
}
template <int VB>
__device__ __forceinline__ void pv_tile(f32x16* o, int vb0, bf16x8 pa0, bf16x8 pa1, bf16x8 pa2, bf16x8 pa3) {
#define TRRD(dst, off) asm volatile("ds_read_b64_tr_b16 %0, %1 offset:%2" : "=&v"(dst) : "v"(vb0), "i"(off) : "memory")
#define PV_D0(d0) do { s16x4 l0, l1, l2, l3, h0, h1, h2, h3; constexpr int b_ = VB * SHM_V + v_rd_off(d0, 0, 0); \
        TRRD(l0, b_); TRRD(h0, b_ + 2048); TRRD(l1, b_ + 4096); TRRD(h1, b_ + 6144); TRRD(l2, b_ + 8192); TRRD(h2, b_ + 10240); TRRD(l3, b_ + 12288); TRRD(h3, b_ + 14336); \
        asm volatile("s_waitcnt lgkmcnt(0)" ::: "memory"); SBAR();   \
        o[d0] = __builtin_amdgcn_mfma_f32_32x32x16_bf16(pa0, (bf16x8){l0[0], l0[1], l0[2], l0[3], h0[0], h0[1], h0[2], h0[3]}, o[d0], 0, 0, 0);   \
        o[d0] = __builtin_amdgcn_mfma_f32_32x32x16_bf16(pa1, (bf16x8){l1[0], l1[1], l1[2], l1[3], h1[0], h1[1], h1[2], h1[3]}, o[d0], 0, 0, 0);   \
        o[d0] = __builtin_amdgcn_mfma_f32_32x32x16_bf16(pa2, (bf16x8){l2[0], l2[1], l2[2], l2[3], h2[0], h2[1], h2[2], h2[3]}, o[d0], 0, 0, 0);   \
        o[d0] = __builtin_amdgcn_mfma_f32_32x32x16_bf16(pa3, (bf16x8){l3[0], l3[1], l3[2], l3[3], h3[0], h3[1], h3[2], h3[3]}, o[d0], 0, 0, 0); } while (0)
    PV_D0(0); PV_D0(1); PV_D0(2); PV_D0(3);
#undef PV_D0
#undef TRRD
}
struct BlockRef { const bf16* Q; const bf16* K; const bf16* V; unsigned char* O; const float* C; int P0, jlo; };
struct Seam { bf16x8 qr[8]; bf16x8 st_v0, st_v1, st_k0, st_k1; };
#define VMW() asm volatile("s_waitcnt vmcnt(0)" ::: "memory")
#define VMWN(n) asm volatile("s_waitcnt vmcnt(%0)" :: "i"(n) : "memory")
#define SLOAD_H(Kp, Vp, k0) do { const char* kb_ = (const char*)(Kp) + (size_t)(k0) * (KP * 2); const char* vb_ = (const char*)(Vp) + (size_t)(k0) * (KP * 2);   \
                         S.st_v0 = *(const bf16x8*)(vb_ + ldoff); S.st_v1 = *(const bf16x8*)(vb_ + 32 * KP * 2 + ldoff);              \
                         S.st_k0 = *(const bf16x8*)(kb_ + ldoff); S.st_k1 = *(const bf16x8*)(kb_ + 32 * KP * 2 + ldoff); } while (0)
#define SWRITE_HK(bf) do { *(bf16x8*)(K_lds + (bf) * SHM_K + kws) = S.st_k0; *(bf16x8*)(K_lds + (bf) * SHM_K + kws + 32 * 256) = S.st_k1; } while (0)
#define SWRITE_HV(bf) do { *(bf16x8*)(V_lds + (bf) * SHM_V + vst0) = S.st_v0; *(bf16x8*)(V_lds + (bf) * SHM_V + vst1) = S.st_v1; } while (0)
#define SWRITE_H(bf) do { SWRITE_HV(bf); SWRITE_HK(bf); } while (0)
__device__ __forceinline__ void attn_prime(const BlockRef& cur, char* lds, Seam& S) {
    const int tid = threadIdx.x, wid = __builtin_amdgcn_readfirstlane(tid >> 6), lane = tid & 63, r32 = lane & 31, hi = lane >> 5;
    const int sr = tid >> 4, sc = (tid & 15) * 8, kws = KSWZ(sr, sc * 2); char* K_lds = lds + 2 * SHM_V;
    const unsigned ldoff = (unsigned)(sr * KP + sc) * 2u, qoff = (unsigned)(r32 * KP + hi * 8) * 2u;
    { const char* qb_ = (const char*)cur.Q + (size_t)(wid * QBLK) * (KP * 2);
      for (int d0 = 0; d0 < 8; ++d0) S.qr[d0] = *(const bf16x8*)(qb_ + qoff + d0 * 32); }
    SLOAD_H(cur.K, cur.V, cur.P0 + QB - KVBLK); VMW(); SWRITE_HK(0);
    __syncthreads();
}
__device__ __forceinline__ void attn_fetch_w0(unsigned* qctr, const unsigned* qm, const unsigned* km, const float* CUM, int q0, int* slot);
struct Fetch { unsigned* qctr; const unsigned* qm; const unsigned* km; const float* CUM; int q0; int* slot; bool on; };
__device__ __forceinline__ void attn_block(const BlockRef& cur, const BlockRef& nxt, char* lds, Seam& S, const int pflags, const Fetch& F) {
    const int tid = threadIdx.x, wid = __builtin_amdgcn_readfirstlane(tid >> 6), lane = tid & 63, r32 = lane & 31, hi = lane >> 5;
    const int NT = (cur.P0 + QB - 1) / KVBLK + 1 - cur.jlo;
    const int qlo = cur.P0 + wid * QBLK, qm = qlo + r32 - 4 * hi;
    char* V_lds = lds; char* K_lds = lds + 2 * SHM_V;
    float* ws = (float*)(lds + LDS_WS) + wid * 64; float* li_l = ws, * al_l = ws + 32;
    char* biasT = lds + LDS_BIAS;
    if (wid == 0 && F.on) attn_fetch_w0(F.qctr, F.qm, F.km, F.CUM, F.q0, F.slot);
    else { const int nkeys = cur.P0 + QB; const float cref = cur.C[cur.P0];
      const unsigned jstep = F.on ? 7168u : 8192u;
      unsigned jo = (unsigned)(F.on ? tid - 64 : tid) * 16u; asm volatile("" : "+v"(jo));
      for (; jo < (unsigned)nkeys * 4u; jo += jstep) { const f32x4 c = *(const f32x4*)((const char*)cur.C + jo); const f32x4 bv = (cref - c) * (1.0f / SCALE);
#pragma unroll
          for (int e = 0; e < 4; ++e) { const float b0 = bv[e]; const unsigned h = f2bf(b0); const float r1 = b0 - bf2f(h); const unsigned m = f2bf(r1); const unsigned l = f2bf(r1 - bf2f(m));
              *(v4u*)(biasT + (size_t)jo * 4 + e * 16) = (v4u){h | (m << 16), l, 0u, 0u}; } } }
    __syncthreads();
    const char* bt0 = biasT + r32 * 16 + hi * 8;
    const v4u qow = {hi ? 0u : 0x3F803F80u, hi ? 0u : 0x00003F80u, 0u, 0u}; const bf16x8 qones = __builtin_bit_cast(bf16x8, qow);
    float m_reg = -1e30f, l_reg = 0; f32x16 o[4] = {};
    const int sr = tid >> 4, sc = (tid & 15) * 8, vst0 = v_st(sr, sc), vst1 = v_st(32 + sr, sc), kws = KSWZ(sr, sc * 2);
    const unsigned ldoff = (unsigned)(sr * KP + sc) * 2u;
    const int vb0 = (int)(uintptr_t)V_lds + v_rd_base(lane);
    const bf16* Kh = cur.K; const bf16* Vh = cur.V;
#define RESC(a) do { if (__any((a) < 1.f)) { if (hi == 0) al_l[r32] = (a); asm volatile("s_waitcnt lgkmcnt(0)" ::: "memory");              \
                     for (int d_ = 0; d_ < 4; ++d_) for (int r = 0; r < 16; ++r) o[d_][r] *= al_l[crow(r, hi)]; } } while (0)
#define KBASE(t) ((cur.jlo + NT - 1 - (t)) * KVBLK)
#define MASKT(P0_, P1_, t) do { const int kb_ = KBASE(t); if (kb_ + KVBLK - 1 > qlo) mask_tile(P0_, P1_, qm - kb_, WBIG); } while (0)
#define SEAM_K0() do { VMWN(8); SWRITE_HK(0); SBAR(); } while (0)
    f32x16 pA0, pA1, pB0, pB1; float mnA, mnB, alA, alB; bf16x8 pa0, pa1, pa2, pa3;
    if (wid >= 4) __builtin_amdgcn_s_setprio(1);
    SWRITE_HV(0); SBAR();
    if (NT > 1) { SLOAD_H(Kh, Vh, KBASE(1)); }
    SBAR(); qkt<0>(pA0, pA1, K_lds, r32, hi, S.qr, bt0 + KBASE(0) * 16, qones, (pflags & 2) != 0);
    MASKT(pA0, pA1, 0); partialSM(pA0, pA1, m_reg, mnA, alA);
    if (NT > 1) { VMW(); SWRITE_H(1); }
    __syncthreads();
#define HALF_STEP(PX0, PX1, mnX, alX, PY0, PY1, alY, t, KB, VB, SB) do {                                                      \
        SBAR(); qkt<KB>(PX0, PX1, K_lds, r32, hi, S.qr, bt0 + KBASE(t) * 16, qones, (pflags & 2) != 0);                                                      \
        finishSM(PY0, PY1, alY, l_reg, pa0, pa1, pa2, pa3); SBAR();                                                           \
        if ((t) + 1 < NT) { SLOAD_H(Kh, Vh, KBASE((t) + 1)); SBAR(); }                                                        \
        pv_tile<VB>(o, vb0, pa0, pa1, pa2, pa3); MASKT(PX0, PX1, (t)); partialSM(PX0, PX1, m_reg, mnX, alX);                  \
        __syncthreads();                                                                                                      \
        if ((t) + 1 < NT) { VMW(); SWRITE_H(SB); }                                                                            \
        RESC(alX); __syncthreads(); } while (0)
    for (int t = 1; t + 1 < NT; t += 2) {
        HALF_STEP(pB0, pB1, mnB, alB, pA0, pA1, alA, t, 1, 0, 0);
        HALF_STEP(pA0, pA1, mnA, alA, pB0, pB1, alB, t + 1, 0, 1, 1);
    }
    const bool even = (NT & 1) == 0;
    if (even) { SBAR(); qkt<1>(pB0, pB1, K_lds, r32, hi, S.qr, bt0 + KBASE(NT - 1) * 16, qones, (pflags & 2) != 0); SBAR(); }
    SLOAD_H(nxt.K, nxt.V, nxt.P0 + QB - KVBLK); SBAR();
    { const unsigned qoff = (unsigned)(r32 * KP + hi * 8) * 2u; const char* qb_ = (const char*)nxt.Q + (size_t)(wid * QBLK) * (KP * 2);
#pragma unroll
      for (int d0 = 0; d0 < 8; ++d0) S.qr[d0] = *(const bf16x8*)(qb_ + qoff + d0 * 32); }
    SBAR();
    finishSM(pA0, pA1, alA, l_reg, pa0, pa1, pa2, pa3); SBAR();
    pv_tile<0>(o, vb0, pa0, pa1, pa2, pa3);
    if (even) { MASKT(pB0, pB1, NT - 1); partialSM(pB0, pB1, m_reg, mnB, alB); __syncthreads(); RESC(alB);
        finishSM(pB0, pB1, alB, l_reg, pa0, pa1, pa2, pa3); SBAR(); pv_tile<1>(o, vb0, pa0, pa1, pa2, pa3); }
    SBAR(); SEAM_K0();
    if (hi == 0) li_l[r32] = l_reg; asm volatile("s_waitcnt lgkmcnt(0)" ::: "memory");
    float rli[16];
#pragma unroll
    for (int r = 0; r < 16; ++r) rli[r] = __builtin_amdgcn_rcpf(li_l[crow(r, hi)]) * YF_SCALE;
    char* Ob = (char*)cur.O + (size_t)(wid * QBLK) * 2048; const unsigned ooff = (unsigned)(4 * hi * 2048 + r32);
#pragma unroll
    for (int r = 0; r < 16; ++r) {
#pragma unroll
        for (int d0 = 0; d0 < 4; ++d0) { const float v = o[d0][r] * rli[r];
            const float vn = __shfl_xor(v, 1);
            if ((r32 & 1) == 0 && !(pflags & 1)) *(unsigned short*)(Ob + (size_t)(((r & 3) + 8 * (r >> 2)) * 2048 + d0 * 32) + ooff) = (unsigned short)cvt_fp8x2(v, vn, 0u, false); } }
    __builtin_amdgcn_s_setprio(0);
    __syncthreads();
#undef RESC
#undef KBASE
#undef MASKT
#undef SEAM_K0
#undef HALF_STEP
}
#undef VMW
#undef VMWN
#undef SLOAD_H
#undef SWRITE_HK
#undef SWRITE_HV
#undef SWRITE_H
__device__ __forceinline__ BlockRef blk_ref(int code, int jlo, const bf16* Q, const bf16* K, const bf16* V, unsigned char* AB, const float* CUM) {
    const int q = code >> 7, i = code & 127, qb = 15 - (i >> 3), bh = q + 8 * (i & 7), b = bh >> 4, h = bh & 15;
    BlockRef r; const size_t row0 = (size_t)b * SEQ;
    r.Q = Q + (row0 + (size_t)qb * QB) * KP + h * D; r.K = K + row0 * KP + h * D; r.V = V + row0 * KP + h * D;
    r.O = AB + (row0 + (size_t)qb * QB) * 2048 + h * D;        r.C = CUM + (size_t)bh * SEQ; r.P0 = qb * QB; r.jlo = jlo;
    return r;
}
__device__ __forceinline__ void attn_fetch_w0(unsigned* qctr, const unsigned* qm, const unsigned* km, const float* CUM, int q0, int* slot) {
    const int lane = threadIdx.x & 63; int res = -1;
    if (lane == 0) { for (int a = 0; a < 8; ++a) { const int q = (q0 + a) & 7; const unsigned t = __hip_atomic_fetch_add(qctr + 64 * q, 1u, __ATOMIC_RELAXED, __HIP_MEMORY_SCOPE_AGENT); if (t < 128u) { res = q * 128 + (int)t; break; } } }
    res = __builtin_amdgcn_readfirstlane(res);
    int jl = 0;
    if (res >= 0) { const int q = res >> 7, i = res & 127, qb = 15 - (i >> 3), bh = q + 8 * (i & 7), P0 = qb * QB;
        const float qn2 = __uint_as_float(__hip_atomic_load(qm + bh * 16 + qb, __ATOMIC_RELAXED, __HIP_MEMORY_SCOPE_AGENT));
        unsigned lo4 = (unsigned)(lane & 15) * 4u, lo256 = (unsigned)lane * 256u + 252u; asm volatile("" : "+v"(lo4), "+v"(lo256));
        float kn2 = (lane <= qb) ? __uint_as_float(__hip_atomic_load((const unsigned*)((const char*)(km + bh * 16) + lo4), __ATOMIC_RELAXED, __HIP_MEMORY_SCOPE_AGENT)) : 0.f;
#pragma unroll
        for (int o = 1; o < 16; o <<= 1) kn2 = fmaxf(kn2, __shfl_xor(kn2, o));
        kn2 = __shfl(kn2, 0);
        const float slack = 2.0f * sqrtf(qn2 * kn2) * SCALE * 1.001f + THR;
        const float* cu = CUM + (size_t)bh * SEQ; const float cref = cu[P0];
        const float cend = (lane < (P0 >> 6)) ? *(const float*)((const char*)cu + lo256) : cref;
        const bool skip = (lane < (P0 >> 6)) && ((cref - cend) + slack < -125.0f);
        const unsigned long long m = __ballot(skip);
        jl = (int)__builtin_ctzll(~m);
    }
    if (lane == 0) { slot[0] = res; slot[1] = jl; }
}
__device__ __forceinline__ int attn_pull(unsigned* qctr, const unsigned* qm, const unsigned* km, const float* CUM, int q0, int* slot, int& jlo) {
    if (threadIdx.x < 64) attn_fetch_w0(qctr, qm, km, CUM, q0, slot);
    __syncthreads();
    const int r = slot[0]; jlo = slot[1];
    __syncthreads();
    return r;
}
__device__ __forceinline__ void attn_phase(char* lds, const bf16* Q, const bf16* K, const bf16* V, unsigned char* AB, const float* CUM, unsigned* qctr, const unsigned* qm, const unsigned* km, int q0, const int pflags) {
    int* slot = (int*)(lds + LDS_BYTES);
    int jc = 0, jn = 0;
    int tc = attn_pull(qctr, qm, km, CUM, q0, slot, jc); if (tc < 0) return;
    BlockRef cur = blk_ref(tc, jc, Q, K, V, AB, CUM);
    Seam S;
    attn_prime(cur, lds, S);
    int tn = attn_pull(qctr, qm, km, CUM, q0, slot, jn);
    for (int par = 0;; par ^= 1) {
        const bool last = tn < 0;
        const BlockRef nxt = last ? cur : blk_ref(tn, jn, Q, K, V, AB, CUM);
        const Fetch F{qctr, qm, km, CUM, q0, slot + 2 * par, !last};
        attn_block(cur, nxt, lds, S, pflags, F);
        if (last) break;
        cur = nxt; tn = slot[2 * par]; jn = slot[2 * par + 1];
    }
}
}

#define XB_TMO      128
#define XB_XCNT(j)  (256  + 64 * (j))
#define XB_XSUB(j)  (1280 + 64 * (j))
#define XB_XGEN(j)  (2304 + 64 * (j))
#define XB_TOP      3328
#define XB_TOPGEN   3392
#define XCD_BAR_WORDS 3456
#define XB_SPIN_CAP (1u << 18)
__device__ __forceinline__ unsigned xb_ld(unsigned* p)              { return __hip_atomic_load(p, __ATOMIC_RELAXED, __HIP_MEMORY_SCOPE_AGENT); }
__device__ __forceinline__ unsigned xb_add(unsigned* p, unsigned v) { return __hip_atomic_fetch_add(p, v, __ATOMIC_RELAXED, __HIP_MEMORY_SCOPE_AGENT); }
__device__ __forceinline__ unsigned xb_xcc_id() { return (unsigned)__builtin_amdgcn_s_getreg((3 << 11) | 20) & 0xFu; }
#define XB_SPIN(cond, bar) do { unsigned _sp = 0; while (cond) { __builtin_amdgcn_s_sleep(1); \
    if ((++_sp & 255u) == 0u) { if (xb_ld(&(bar)[XB_TMO])) break; if (_sp > XB_SPIN_CAP) { atomicAdd(&(bar)[XB_TMO], 1u); break; } } } } while (0)
struct XcdBarrier { unsigned* bar; unsigned x; volatile LAS unsigned* st; };
__device__ __forceinline__ XcdBarrier xcd_barrier_post(unsigned* bar, volatile LAS unsigned* st) {
    XcdBarrier b; b.bar = bar; b.x = xb_xcc_id(); b.st = st;
    if (threadIdx.x == 0) (void)xb_add(&bar[XB_XCNT(b.x)], 1u);
    return b;
}
__device__ __forceinline__ void xcd_barrier_complete(unsigned* bar, unsigned x, unsigned& nloc, unsigned& nx) {
    const unsigned G = gridDim.x * gridDim.y * gridDim.z;
    unsigned sum, cnt, mine, sp = 0u;
    for (;;) {
        sum = 0u; cnt = 0u; mine = 0u;
#pragma unroll
        for (unsigned j = 0; j < 16; ++j) { const unsigned c = xb_ld(&bar[XB_XCNT(j)]); sum += c; cnt += (c > 0u) ? 1u : 0u; mine = (j == x) ? c : mine; }
        if (sum == G) break;
        __builtin_amdgcn_s_sleep(1);
        if ((++sp & 255u) == 0u) { if (xb_ld(&bar[XB_TMO])) break; if (sp > XB_SPIN_CAP) { atomicAdd(&bar[XB_TMO], 1u); break; } }
    }
    nloc = mine > 0u ? mine : 1u; nx = cnt > 0u ? cnt : 1u;
}
__device__ __forceinline__ void xcd_barrier(const XcdBarrier& b) {
    asm volatile("s_waitcnt vmcnt(0)" ::: "memory");
    __syncthreads();
    if (threadIdx.x == 0) {
        unsigned* bar = b.bar;
        __builtin_amdgcn_s_waitcnt(0);
        unsigned nloc = b.st[0], nx = b.st[1];
        if (nloc == 0u) { xcd_barrier_complete(bar, b.x, nloc, nx); b.st[0] = nloc; b.st[1] = nx; }
        const unsigned old = xb_add(&bar[XB_XSUB(b.x)], 1u);
        const unsigned gen = old / nloc;
        if (old + 1u == (gen + 1u) * nloc) {
            __builtin_amdgcn_fence(__ATOMIC_RELEASE, "agent");
            asm volatile("s_waitcnt vmcnt(0)" ::: "memory");
            const unsigned og = xb_add(&bar[XB_TOP], 1u);
            const unsigned tg = og / nx;
            if (og + 1u == (tg + 1u) * nx) xb_add(&bar[XB_TOPGEN], 1u);
            else XB_SPIN(xb_ld(&bar[XB_TOPGEN]) == tg, bar);
            __builtin_amdgcn_fence(__ATOMIC_ACQUIRE, "agent");
            xb_add(&bar[XB_XGEN(b.x)], 1u);
            asm volatile("s_waitcnt vmcnt(0)" ::: "memory");
        } else {
            XB_SPIN(xb_ld(&bar[XB_XGEN(b.x)]) == gen, bar);
            __builtin_amdgcn_fence(__ATOMIC_ACQUIRE, "agent");
            asm volatile("s_waitcnt vmcnt(0)" ::: "memory");
        }
    }
    __syncthreads();
}

__device__ __forceinline__ void tr_load64(const float* W, int ldw, f32x4 (&v)[16], int lane) {
#pragma unroll
    for (int i = 0; i < 16; ++i) { const int kk = 4 * i + (lane >> 4); v[i] = __builtin_nontemporal_load((const f32x4*)(W + (size_t)kk * ldw + (lane & 15) * 4)); }
}
__device__ __forceinline__ void tr_store64(const f32x4 (&v)[16], bf16* WT, int ldt, LAS float* scr, int lane) {
#pragma unroll
    for (int i = 0; i < 16; ++i) { const int kk = 4 * i + (lane >> 4); LAS float* s = scr + kk * 65 + (lane & 15) * 4; s[0] = v[i][0]; s[1] = v[i][1]; s[2] = v[i][2]; s[3] = v[i][3]; }
    LDS_WAIT(); asm volatile("" ::: "memory");
    const int c = lane & 7;
#pragma unroll
    for (int j = 0; j < 8; ++j) { const int n = (lane >> 3) + 8 * j; const LAS float* s = scr + (8 * c) * 65 + n;
        v4u o; o.x = cvt2(s[0], s[65]); o.y = cvt2(s[130], s[195]); o.z = cvt2(s[260], s[325]); o.w = cvt2(s[390], s[455]);
        *(v4u*)(WT + (size_t)n * ldt + 8 * c) = o; }
    LDS_WAIT(); asm volatile("" ::: "memory");
}
#define WinT ((bf16*)(ws + WS_WIN))
#define WabT ((bf16*)(ws + WS_WAB))
#define WB8 ((unsigned char*)(ws + WS_WB8))
#define XN8 ((unsigned char*)(ws + WS_XN8))
#define WQKV8 ((unsigned char*)(ws + WS_WQKV8))
#define PART ((bf16*)(ws + WS_PART))
#define YF8 ((unsigned char*)(ws + WS_YF8))
#define WoT ((bf16*)(ws + WS_WO))
#define WrHi ((bf16*)(ws + WS_WR))
#define WrLo (WrHi + 80 * 2048)
#define XN ((bf16*)(ws + WS_XN))
#define Zb ((bf16*)(ws + WS_Z))
#define XBC ((bf16*)(ws + WS_XBC))
#define Qb ((bf16*)(ws + WS_Q))
#define Kb ((bf16*)(ws + WS_K))
#define Vb ((bf16*)(ws + WS_V))
#define Gb ((bf16*)(ws + WS_G))
#define DTF ((float*)(ws + WS_DTF))
#define XC ((bf16*)(ws + WS_XC))
#define DT ((float*)(ws + WS_DT))
#define CUM ((float*)(ws + WS_CUM))
#define SS ((float*)(ws + WS_SS))
#define AB ((bf16*)(ws + WS_AB))
#define MIX ((bf16*)(ws + WS_MIX))
#define Hf ((bf16*)(ws + WS_H))
#define WguT ((bf16*)(ws + WS_WGU))
#define WdA ((bf16*)(ws + WS_WDA))
#define WdB ((bf16*)(ws + WS_WDB))
#define U2 ((bf16*)(ws + WS_U2))
#define HDN ((bf16*)(ws + WS_HDN))
#define YM ((bf16*)(ws + WS_YM))
#define tok_e ((int*)(ws + WS_TAB + TAB_E))
#define tok_w ((float*)(ws + WS_TAB + TAB_W))
#define tok_rank ((int*)(ws + WS_TAB + TAB_RANK))
#define tok_row ((int*)(ws + WS_TAB + TAB_ROW))
#define tile_tab ((unsigned*)(ws + WS_TAB + TAB_TILE))
#define row_tok ((int*)(ws + WS_TAB + TAB_ROWTOK))
#define ecnt (ctl + CW_CNT)
#define in_x ARGP(0)
#define norm_mix_w ARGP(1)
#define w_in ARGP(2)
#define conv_w ARGP(3)
#define conv_b ARGP(4)
#define dt_bias ARGP(5)
#define a_log ARGP(6)
#define d_skip ARGP(7)
#define ssd_norm_w ARGP(8)
#define fox_f_bias ARGP(9)
#define w_proj_ssd ARGP(10)
#define w_proj_fox ARGP(11)
#define w_out ARGP(12)
#define norm_moe_w ARGP(13)
#define w_rg ARGP(14)
#define b_rg ARGP(15)
#define w_re ARGP(16)
#define b_re ARGP(17)
#define w_gate ARGP(18)
#define w_up ARGP(19)
#define w_down ARGP(20)
#define norm_final_w ARGP(21)
__device__ __forceinline__ void tr_store64_f8(const f32x4 (&v)[16], unsigned char* WT, int ldt, LAS float* scr, int lane, float sc) {
#pragma unroll
    for (int i = 0; i < 16; ++i) { const int kk = 4 * i + (lane >> 4); LAS float* s = scr + kk * 65 + (lane & 15) * 4; s[0] = v[i][0]; s[1] = v[i][1]; s[2] = v[i][2]; s[3] = v[i][3]; }
    LDS_WAIT(); asm volatile("" ::: "memory");
    const int c = lane & 3;
#pragma unroll
    for (int j = 0; j < 4; ++j) { const int n = (lane >> 2) + 16 * j; const LAS float* s = scr + (16 * c) * 65 + n;
        v4u o; o.x = cvt_fp8x4(s[0] * sc, s[65] * sc, s[130] * sc, s[195] * sc); o.y = cvt_fp8x4(s[260] * sc, s[325] * sc, s[390] * sc, s[455] * sc);
        o.z = cvt_fp8x4(s[520] * sc, s[585] * sc, s[650] * sc, s[715] * sc); o.w = cvt_fp8x4(s[780] * sc, s[845] * sc, s[910] * sc, s[975] * sc);
        *(v4u*)(WT + (size_t)n * ldt + 16 * c) = o; }
    LDS_WAIT(); asm volatile("" ::: "memory");
}
typedef const float* cfp_t;
#define ARGP(k) (*(const volatile __attribute__((address_space(4))) cfp_t*)(kin + (k)))
#define CONV_I_G (NEXP * 32 * 8)
#define WGU_PRESCALE 64.0f
#define TR_STORE_ANY(v_, d_, lt_, scr__) do { if ((lt_) < 0) tr_store64_f8(v_, (unsigned char*)(d_), -(lt_), scr__, lane, WGU_PRESCALE); else tr_store64(v_, d_, lt_, scr__, lane); } while (0)
#define EXPERT_DECODE(it_, src_, ldw_, dst_, ldt_) do { int r_ = (it_); \
        if (r_ < 2 * CONV_I_G) { const int isup_ = r_ >= CONV_I_G; if (isup_) r_ -= CONV_I_G; const int e_ = r_ >> 8, kb_ = (r_ >> 3) & 31, nb_ = r_ & 7; \
            src_ = (isup_ ? w_up : w_gate) + ((size_t)e_ * 2048 + 64 * kb_) * 512 + 64 * nb_; ldw_ = 512; \
            dst_ = (bf16*)((unsigned char*)WguT + ((size_t)e_ * 1024 + (nb_ >> 1) * 256 + isup_ * 128 + (nb_ & 1) * 64) * 2048 + 64 * kb_); ldt_ = -2048;   } \
        else { r_ -= 2 * CONV_I_G; const int e_ = r_ >> 8, kb_ = (r_ >> 5) & 7, nb_ = r_ & 31; \
            src_ = w_down + ((size_t)e_ * 512 + 64 * kb_) * 2048 + 64 * nb_; ldw_ = 2048; \
            dst_ = (bf16*)((unsigned char*)(e_ < WD_SPLIT ? WdA : WdB) + (size_t)(e_ < WD_SPLIT ? e_ : e_ - WD_SPLIT) * 2048 * 512 + (size_t)(64 * nb_) * 512 + 64 * kb_); ldt_ = -512;   } } while (0)
#define EXPERT_CONVERT(it_lo, it_hi) EXPERT_CONVERT_S(it_lo, it_hi, gw, NGW)
#define EXPERT_CONVERT_S(it_lo, it_hi, first_, stride_) do { LAS float* scr_ = (LAS float*)(ldsl + wave * 16640); \
        int it0_ = (it_lo) + (first_); \
        if (it0_ < (it_hi)) { const float* s0_; bf16* d0_; int lw0_, lt0_; f32x4 v0_[16]; \
            EXPERT_DECODE(it0_, s0_, lw0_, d0_, lt0_); tr_load64(s0_, lw0_, v0_, lane); \
            for (;;) { const int it1_ = it0_ + (stride_); const bool has1_ = it1_ < (it_hi); const float* s1_ = s0_; bf16* d1_ = d0_; int lw1_ = lw0_, lt1_ = lt0_; f32x4 v1_[16]; \
                if (has1_) { EXPERT_DECODE(it1_, s1_, lw1_, d1_, lt1_); tr_load64(s1_, lw1_, v1_, lane); } \
                TR_STORE_ANY(v0_, d0_, lt0_, scr_); \
                if (!has1_) break; \
                _Pragma("unroll") for (int i_ = 0; i_ < 16; ++i_) v0_[i_] = v1_[i_]; \
                d0_ = d1_; lt0_ = lt1_; s0_ = s1_; lw0_ = lw1_; it0_ = it1_; } } } while (0)
#define CONV_NEXT(var_) do { if (pos_ < end_) { var_ = pos_++; } else { unsigned b_ = 0u; if (lane == 0) b_ = __hip_atomic_fetch_add(cctr_, 4u, RLX_AGENT); b_ = (unsigned)__builtin_amdgcn_readfirstlane((int)b_); \
        if ((int)b_ >= (n_items_)) { var_ = -1; } else { var_ = (int)b_; pos_ = (int)b_ + 1; end_ = ((int)b_ + 4 < (n_items_)) ? (int)b_ + 4 : (n_items_); } } } while (0)
#define EXPERT_CONVERT_DYN(ctr, n_items) do { LAS float* scr_ = (LAS float*)(ldsl + wave * 16640); unsigned* cctr_ = (ctr); const int n_items_ = (n_items); int pos_ = 0, end_ = 0; \
        int it0_; CONV_NEXT(it0_); \
        if (it0_ >= 0) { const float* s0_; bf16* d0_; int lw0_, lt0_; f32x4 v0_[16]; \
            EXPERT_DECODE(it0_, s0_, lw0_, d0_, lt0_); tr_load64(s0_, lw0_, v0_, lane); \
            for (;;) { int it1_; CONV_NEXT(it1_); const bool has1_ = it1_ >= 0; const float* s1_ = s0_; bf16* d1_ = d0_; int lw1_ = lw0_, lt1_ = lt0_; f32x4 v1_[16]; \
                if (has1_) { EXPERT_DECODE(it1_, s1_, lw1_, d1_, lt1_); tr_load64(s1_, lw1_, v1_, lane); } \
                TR_STORE_ANY(v0_, d0_, lt0_, scr_); \
                if (!has1_) break; \
                _Pragma("unroll") for (int i_ = 0; i_ < 16; ++i_) v0_[i_] = v1_[i_]; \
                d0_ = d1_; lt0_ = lt1_; s0_ = s1_; lw0_ = lw1_; } } } while (0)
struct Args { const float* in[22]; float* out; unsigned char* ws; int ph_lo, ph_hi, sub, pad; };
constexpr int NPHASE = 11;

__global__ void __launch_bounds__(512, 2) mega_fwd(Args args) {
    extern __shared__ __attribute__((aligned(16))) unsigned char lds[];
    LAS unsigned char* ldsl = (LAS unsigned char*)lds;
    volatile LAS unsigned* MISC = (volatile LAS unsigned*)(ldsl + MISC_OFF);
    const int tid = threadIdx.x, lane = tid & 63, wave = __builtin_amdgcn_readfirstlane(tid >> 6);
    const int G = gridDim.x, bx = blockIdx.x;
    const int gw = bx * 8 + wave, NGW = G * 8;
    const __attribute__((address_space(4))) cfp_t* kin = (const __attribute__((address_space(4))) cfp_t*)__builtin_amdgcn_kernarg_segment_ptr();
    unsigned char* ws = args.ws;
    unsigned* ctl = (unsigned*)(ws + WS_CTL);
    for (int u = tid; u < (LDS_BYTES - LDSCTL_OFF) / 4; u += 512) ((LAS unsigned*)(ldsl + LDSCTL_OFF))[u] = 0u;
    __syncthreads();
    const int lo = args.ph_lo, hi = args.ph_hi, sub = args.sub;
    XcdBarrier bar; bar.bar = ctl + CW_BAR; bar.x = 0; bar.st = nullptr;
    if (hi - lo > 1) bar = xcd_barrier_post(ctl + CW_BAR, MISC + 8);
#define IN(k) (lo <= (k) && (k) < hi)
#define SEAM(k) do { if (IN(k) && IN((k) + 1)) xcd_barrier(bar); } while (0)

    if (IN(0)) {
        LAS float* scr = (LAS float*)(ldsl + wave * 16640);
        constexpr int I_Z = 32 * 32, I_XS = 32 * 32, I_BC = 32 * 16, I_QKV = 32 * 96, I_GS = 32 * 32, I_GF = 32 * 32, I_SQ = 32 * 32;
        constexpr int NITEMS = I_Z + I_XS + I_BC + I_QKV + I_GS + I_GF + 3 * I_SQ;
#define P0_DECODE(it_, srcp_, ldw_, dstp_, ldt_) do { int r = (it_); const float* src; int nb_per; bf16* dst; \
            if (r < I_Z) { src = w_in + SRC_Z; ldw_ = NPROJ; dst = WinT + (size_t)DST_Z * 2048; ldt_ = 2048; nb_per = 32; } \
            else if ((r -= I_Z) < I_XS) { src = w_in + SRC_XBC; ldw_ = NPROJ; dst = WinT + (size_t)DST_XBC * 2048; ldt_ = 2048; nb_per = 32; }        \
            else if ((r -= I_XS) < I_BC) { src = w_in + SRC_XBC + 2048; ldw_ = NPROJ; dst = (bf16*)WQKV8; ldt_ = -2048; nb_per = 16; }        \
            else if ((r -= I_BC) < I_QKV) { src = w_in + SRC_QKV; ldw_ = NPROJ; dst = (bf16*)(WQKV8 + (size_t)1024 * 2048); ldt_ = -2048; nb_per = 96; }        \
            else if ((r -= I_QKV) < I_GS) { src = w_in + SRC_GATE; ldw_ = NPROJ; dst = WinT + (size_t)DST_GATE * 2048; ldt_ = 2048; nb_per = 32; }        \
            else if ((r -= I_GS) < I_GF) { src = w_in + SRC_GATE + 2048; ldw_ = NPROJ; dst = (bf16*)(WQKV8 + (size_t)7168 * 2048); ldt_ = -2048; nb_per = 32; }        \
            else if ((r -= I_GF) < I_SQ) { src = w_proj_ssd; ldw_ = 2048; dst = WabT; ldt_ = 4096; nb_per = 32; } \
            else if ((r -= I_SQ) < I_SQ) { src = w_proj_fox; ldw_ = 2048; dst = (bf16*)WB8; ldt_ = -2048; nb_per = 32; }        \
            else { r -= I_SQ; src = w_out; ldw_ = 2048; dst = WoT; ldt_ = 2048; nb_per = 32; } \
            const int kb = r / nb_per, nb = r % nb_per; srcp_ = src + (size_t)(64 * kb) * ldw_ + 64 * nb; \
            dstp_ = ldt_ < 0 ? (bf16*)((unsigned char*)dst + (size_t)(64 * nb) * (size_t)(-ldt_) + 64 * kb) : dst + (size_t)(64 * nb) * ldt_ + 64 * kb; } while (0)
        { int itc = gw;
          if (itc < NITEMS) { const float* sc; bf16* dc; int lwc, ltc; f32x4 vc[16]; P0_DECODE(itc, sc, lwc, dc, ltc); tr_load64(sc, lwc, vc, lane);
            for (;;) { const int itn = itc + NGW; const bool more = itn < NITEMS; const float* sn = sc; bf16* dn = dc; int lwn = lwc, ltn = ltc; f32x4 vn[16];
                if (more) { P0_DECODE(itn, sn, lwn, dn, ltn); tr_load64(sn, lwn, vn, lane); }
                TR_STORE_ANY(vc, dc, ltc, scr);
                if (!more) break;
#pragma unroll
                for (int i = 0; i < 16; ++i) vc[i] = vn[i];
                itc = itn; sc = sn; dc = dn; lwc = lwn; ltc = ltn; } } }
#undef P0_DECODE
        for (int idx = bx * 512 + tid; idx < 48 * 2048; idx += G * 512) { const int r = idx >> 11, k = idx & 2047;
            const float v = (r < 32) ? w_in[(size_t)k * NPROJ + SRC_DT + r] : w_in[(size_t)k * NPROJ + SRC_F + (r - 32)];
            WinT[(size_t)(DST_SMALL + r) * 2048 + k] = (bf16)f2bf(v); }
        for (int idx = bx * 512 + tid; idx < 80 * 2048; idx += G * 512) { const int r = idx >> 11, k = idx & 2047;
            float v = 0.f; if (r < 8) v = w_rg[(size_t)k * 8 + r]; else if (r < 72) v = w_re[(size_t)k * 64 + (r - 8)];
            const unsigned hb = f2bf(v); WrHi[idx] = (bf16)hb; WrLo[idx] = (bf16)f2bf(v - bf2f(hb)); }
        { f32x4 xv[2][8];
#define P0_LOAD(S_, m_) do { const f32x4* xr_ = (const f32x4*)(in_x + (size_t)(m_) * DM); \
            _Pragma("unroll") for (int j_ = 0; j_ < 4; ++j_) { xv[S_][2 * j_] = __builtin_nontemporal_load(xr_ + (j_ * 64 + lane) * 2); xv[S_][2 * j_ + 1] = __builtin_nontemporal_load(xr_ + (j_ * 64 + lane) * 2 + 1); } } while (0)
          int m = gw; if (m < T) P0_LOAD(0, m);
          for (int it = 0; m < T; m += NGW, ++it) {
#pragma unroll
            for (int par = 0; par < 2; ++par) { if ((it & 1) == par) {
              if (m + NGW < T) P0_LOAD(par ^ 1, m + NGW);
              float sacc = 0.f;
#pragma unroll
              for (int j = 0; j < 8; ++j) { const f32x4 q = xv[par][j]; sacc += (q[0] * q[0] + q[1] * q[1]) + (q[2] * q[2] + q[3] * q[3]); }
              const float rstd = 1.0f / sqrtf(wave_sum(sacc) * (1.f / DM) + EPS);
#pragma unroll
              for (int j = 0; j < 4; ++j) { const f32x4* wp = (const f32x4*)(norm_mix_w) + (j * 64 + lane) * 2; const f32x4 w0 = wp[0], w1 = wp[1]; const f32x4 a = xv[par][2 * j] * rstd * w0, bq = xv[par][2 * j + 1] * rstd * w1;
                  v4u o; o.x = pk2(a[0], a[1]); o.y = pk2(a[2], a[3]); o.z = pk2(bq[0], bq[1]); o.w = pk2(bq[2], bq[3]);
                  *(v4u*)(XN + (size_t)m * DM + (j * 64 + lane) * 8) = o;
                  const f32x4 a8 = a * XN_SCALE, b8 = bq * XN_SCALE;
                  *(v2u*)(XN8 + (size_t)m * DM + (j * 64 + lane) * 8) = (v2u){cvt_fp8x4(a8[0], a8[1], a8[2], a8[3]), cvt_fp8x4(b8[0], b8[1], b8[2], b8[3])}; }
            } }
          }
#undef P0_LOAD
        }
    }
    SEAM(0);

    if (IN(1)) {
        { pg8::Shape g{2048, 2048, 2048};
          pg8::SchedCols S{(const char*)XN, (const char*)WinT, T / 256, 24, G, bx, (size_t)256 * 2048 * 2, (size_t)256 * 2048 * 2, 0, 16, 28, true};
          pg8::EpiProj E{Zb, XBC, Qb, Kb, Vb, Gb, (LAS float*)(ldsl + pg8::STAGE_BYTES), ctl + CW_QM, ctl + CW_KM, 1.0f};
          pg8::gemm_phase<pg8::EpiProj, pg8::SchedCols, true>(ldsl, g, S, E); }
        __syncthreads();
        { pg8::Shape g{1024, 1024, 1024};
          pg8::SchedCols S{(const char*)XN8, (const char*)WQKV8, T / 256, 36, G, bx, (size_t)256 * 2048, (size_t)256 * 2048, 16, 28, 8, false};
          pg8::EpiProj E{Zb, XBC, Qb, Kb, Vb, Gb, (LAS float*)(ldsl + pg8::STAGE_BYTES), ctl + CW_QM, ctl + CW_KM, 1.0f / (WGU_PRESCALE * XN_SCALE)};
          pg8::gemm_phase<pg8::EpiProj, pg8::SchedCols, true, false, true>(ldsl, g, S, E); }
        for (int item = gw; item < (T / 16) * 2; item += NGW) { const int tile = item >> 1, kh = item & 1;
            const bf16* ap = XN + (size_t)(tile * 16 + (lane & 15)) * 2048 + kh * 1024 + 8 * (lane >> 4);
            const bf16* bp = WinT + (size_t)(DST_SMALL + (lane & 15)) * 2048 + kh * 1024 + 8 * (lane >> 4);
            f32x4 acc[3]; acc[0] = (f32x4){0.f, 0.f, 0.f, 0.f}; acc[1] = acc[0]; acc[2] = acc[0];
#pragma unroll 8
            for (int ks = 0; ks < 32; ++ks) { const bf16x8 a = *(const bf16x8*)(ap + ks * 32);
#pragma unroll
                for (int ct = 0; ct < 3; ++ct) { const bf16x8 bb = *(const bf16x8*)(bp + (size_t)ct * 16 * 2048 + ks * 32); acc[ct] = __builtin_amdgcn_mfma_f32_16x16x32_bf16(a, bb, acc[ct], 0, 0, 0); } }
            float* dp = DTF + (size_t)kh * T * 64 + (size_t)(tile * 16 + (lane >> 4) * 4) * 64 + (lane & 15);
#pragma unroll
            for (int ct = 0; ct < 3; ++ct)
#pragma unroll
                for (int r = 0; r < 4; ++r) dp[r * 64 + ct * 16] = acc[ct][r]; }
    }
    SEAM(1);

    if (IN(2)) {
        { v4u rw[2][11];
#define CV_LOAD(S_, idx_) do { const int tb_ = (idx_) / 384, c8_ = (idx_) - tb_ * 384, t0_ = tb_ * 8, s0_ = t0_ & (SEQ - 1); \
            _Pragma("unroll") for (int j_ = 0; j_ < 11; ++j_) { if (j_ >= 3 || s0_ > 0) rw[S_][j_] = *(const v4u*)(XBC + (size_t)(t0_ - 3 + j_) * CONVD + c8_ * 8); else rw[S_][j_] = (v4u){0u, 0u, 0u, 0u}; } } while (0)
          const int NIT = (T / 8) * 384, step = G * 512;
          int idx = bx * 512 + tid; if (idx < NIT) CV_LOAD(0, idx);
          for (int it = 0; idx < NIT; idx += step, ++it) {
#pragma unroll
            for (int par = 0; par < 2; ++par) { if ((it & 1) == par) {
              if (idx + step < NIT) CV_LOAD(par ^ 1, idx + step);
              const int tb = idx / 384, c8 = idx - tb * 384, ch = c8 * 8, t0 = tb * 8;
              float wt[4][8], bs[8];
#pragma unroll
              for (int w = 0; w < 4; ++w) { const f32x4 w0 = *(const f32x4*)(conv_w + w * CONVD + ch), w1 = *(const f32x4*)(conv_w + w * CONVD + ch + 4);
                  wt[w][0] = w0[0]; wt[w][1] = w0[1]; wt[w][2] = w0[2]; wt[w][3] = w0[3]; wt[w][4] = w1[0]; wt[w][5] = w1[1]; wt[w][6] = w1[2]; wt[w][7] = w1[3]; }
              { const f32x4 b0 = *(const f32x4*)(conv_b + ch), b1 = *(const f32x4*)(conv_b + ch + 4); bs[0] = b0[0]; bs[1] = b0[1]; bs[2] = b0[2]; bs[3] = b0[3]; bs[4] = b1[0]; bs[5] = b1[1]; bs[6] = b1[2]; bs[7] = b1[3]; }
#pragma unroll
              for (int o = 0; o < 8; ++o) { float a[8];
#pragma unroll
                  for (int e = 0; e < 8; ++e) a[e] = bs[e];
#pragma unroll
                  for (int w = 0; w < 4; ++w) { const v4u r = rw[par][o + w];
                      a[0] += wt[w][0] * bflo(r.x); a[1] += wt[w][1] * bfhi(r.x); a[2] += wt[w][2] * bflo(r.y); a[3] += wt[w][3] * bfhi(r.y);
                      a[4] += wt[w][4] * bflo(r.z); a[5] += wt[w][5] * bfhi(r.z); a[6] += wt[w][6] * bflo(r.w); a[7] += wt[w][7] * bfhi(r.w); }
#pragma unroll
                  for (int e = 0; e < 8; ++e) a[e] = siluf_(a[e]);
                  v4u ov; ov.x = cvt2(a[0], a[1]); ov.y = cvt2(a[2], a[3]); ov.z = cvt2(a[4], a[5]); ov.w = cvt2(a[6], a[7]);
                  *(v4u*)(XC + (size_t)(t0 + o) * CONVD + ch) = ov; }
            } }
          }
#undef CV_LOAD
        }
        for (int idx = bx * 512 + tid; idx < T * 32; idx += G * 512) { const int h = idx & 31, t = idx >> 5;
            const float v = DTF[(size_t)t * 64 + h] + DTF[(size_t)T * 64 + (size_t)t * 64 + h] + dt_bias[h];
            DT[((size_t)(t >> 12) * 32 + h) * SEQ + (t & (SEQ - 1))] = fmaxf(v, 0.f) + log1pf(__expf(-fabsf(v))); }
        if (wave == 7) for (int sid = bx; sid < 64; sid += G) { const int b = sid >> 4, hh = sid & 15; const float fb = fox_f_bias[hh];
            const float* src = DTF + ((size_t)b * SEQ + (size_t)lane * 64) * 64 + 32 + hh; float v[64];
#pragma unroll
            for (int i = 0; i < 64; ++i) v[i] = src[(size_t)i * 64] + src[(size_t)T * 64 + (size_t)i * 64];
            float run = 0.f;
#pragma unroll
            for (int i = 0; i < 64; ++i) { const float z = v[i] + fb; run += -(fmaxf(-z, 0.f) + log1pf(__expf(-fabsf(z)))); v[i] = run; }
            float tot = run;
#pragma unroll
            for (int o = 1; o < 64; o <<= 1) { const float n = __shfl_up(tot, o); if (lane >= o) tot += n; }
            const float base = tot - run;
            float* dst = CUM + (size_t)sid * SEQ + lane * 64;
#pragma unroll
            for (int i = 0; i < 64; i += 4) *(f32x4*)(dst + i) = (f32x4){v[i] + base, v[i + 1] + base, v[i + 2] + base, v[i + 3] + base}; }
    }
    SEAM(2);

    if (IN(3)) {
        constexpr int CONV_P3_END = 2 * CONV_I_G + WD_SPLIT * 256;
        const int GH = G >> 1;
        if ((sub & 2) && bx < GH) {
            constexpr int RS = 272, XSt = 144;
            LAS unsigned char* Cs = ldsl; LAS unsigned char* Bs = ldsl + 34816; LAS unsigned char* Ms = Cs;
            LAS unsigned char* Xs = ldsl + 69632; LAS unsigned char* XWs = ldsl + 88064; LAS unsigned char* S16 = ldsl + 106496;
            LAS float* A2 = (LAS float*)(ldsl + 123904 + wave * 1536); LAS float* LW2 = A2 + 128; LAS float* WW = A2 + 256;
            const int l15 = lane & 15, g4 = lane >> 4, r32 = lane & 31, hi5 = lane >> 5, trq = (lane & 15) >> 2, trp = lane & 3;
            const int prow = tid >> 4, pcol = tid & 15, xrow = tid >> 3, xc8 = tid & 7;
            typedef short v4i16_t __attribute__((ext_vector_type(4)));
            constexpr float L2E = 1.4426950408889634f;
#define SSD_TR(p) __builtin_amdgcn_ds_read_tr16_b64_v4i16((LAS v4i16_t*)(p))
#define SSD_MFMA16(a, b, c) __builtin_amdgcn_mfma_f32_16x16x32_bf16(a, b, c, 0, 0, 0)
            for (int unit0 = bx; unit0 < NB * SSD_H; unit0 += GH) {
                const int unit = (GH == 128) ? ((((unit0 & 7) * 2 + ((unit0 >> 3) >> 3)) << 3) | ((unit0 >> 3) & 7)) : unit0;
                const int b = unit >> 5, h = unit & 31, g = h >> 3;
                const float ah = -__expf(a_log[h]), Dh = d_skip[h];
                const int chx = h * 64;
                float nwv[4];
#pragma unroll
                for (int pt = 0; pt < 4; ++pt) nwv[pt] = ssd_norm_w[chx + 16 * pt + l15];
                f32x4 Sacc[4];
#pragma unroll
                for (int pt = 0; pt < 4; ++pt) Sacc[pt] = (f32x4){0.f, 0.f, 0.f, 0.f};
                const unsigned cvo0 = (unsigned)(prow * CONVD + pcol * 8) * 2u, xvo0 = (unsigned)(xrow * CONVD + xc8 * 8) * 2u, dvo0 = (unsigned)lane * 8u;
                const unsigned zvo0 = (unsigned)((16 * wave + 4 * g4) * 2048 + l15) * 2u, ovo0 = (unsigned)((16 * wave + 4 * g4) * 4096 + l15) * 2u, svo0 = (unsigned)(16 * wave + 4 * g4 + l15) * 128u;
                unsigned cvo = cvo0, xvo = xvo0, dvo = dvo0, zvo = zvo0, ovo = ovo0, svo = svo0;
#define SSD_OPAQUE() asm volatile("" : "+v"(cvo), "+v"(xvo), "+v"(dvo), "+v"(zvo), "+v"(ovo), "+v"(svo))
                v4u cst[4], bst[4], xst[2]; float dt0, dt1, tot_cur = 0.f; unsigned short zn[16], zr[16];
#define SSD_LOAD(cc) do { const size_t tb_ = (size_t)b * SEQ + (size_t)(cc) * 128; \
                    const char* cb_ = (const char*)(XC + tb_ * CONVD + 2560 + g * 128); const char* bb_ = (const char*)(XC + tb_ * CONVD + 2048 + g * 128); \
                    _Pragma("unroll") for (int i_ = 0; i_ < 4; ++i_) { cst[i_] = *(const v4u*)(cb_ + (size_t)i_ * (32 * CONVD * 2) + cvo); bst[i_] = *(const v4u*)(bb_ + (size_t)i_ * (32 * CONVD * 2) + cvo); } \
                    { const char* xb_ = (const char*)(XC + tb_ * CONVD + chx); xst[0] = *(const v4u*)(xb_ + xvo); xst[1] = *(const v4u*)(xb_ + (size_t)(64 * CONVD * 2) + xvo); } \
                    { const f32x2_t d2_ = *(const f32x2_t*)((const char*)(DT + ((size_t)b * 32 + h) * SEQ + (size_t)(cc) * 128) + dvo); dt0 = d2_[0]; dt1 = d2_[1]; } } while (0)
#define SSD_ZLOAD(dst, cc) do { const char* zp_ = (const char*)(Zb + ((size_t)b * SEQ + (size_t)(cc) * 128) * 2048 + chx); \
                    _Pragma("unroll") for (int pt_ = 0; pt_ < 4; ++pt_) _Pragma("unroll") for (int r_ = 0; r_ < 4; ++r_) dst[pt_ * 4 + r_] = *(const bf16*)(zp_ + (r_ * 4096 + 32 * pt_) + zvo); } while (0)
#define SSD_WRITE() do { const float a0_ = dt0 * ah, a1_ = a0_ + dt1 * ah; const float inc_ = wave_incl_scan(a1_); \
                    const float ex_ = inc_ - a1_, c0_ = ex_ + a0_, c1_ = inc_; const float tot_ = __builtin_bit_cast(float, __builtin_amdgcn_readlane(__builtin_bit_cast(int, inc_), 63)); tot_cur = tot_; \
                    *(LAS f32x2_t*)(A2 + 2 * lane) = (f32x2_t){c0_ * L2E, c1_ * L2E}; \
                    *(LAS f32x2_t*)(LW2 + 2 * lane) = (f32x2_t){__log2f(dt0) - c0_ * L2E, __log2f(dt1) - c1_ * L2E}; \
                    *(LAS f32x2_t*)(WW + 2 * lane) = (f32x2_t){dt0 * __expf(tot_ - c0_), dt1 * __expf(tot_ - c1_)}; \
                    _Pragma("unroll") for (int i_ = 0; i_ < 4; ++i_) { *(LAS v4u*)(Cs + (prow + 32 * i_) * RS + pcol * 16) = cst[i_]; *(LAS v4u*)(Bs + (prow + 32 * i_) * RS + pcol * 16) = bst[i_]; } \
                    _Pragma("unroll") for (int i_ = 0; i_ < 2; ++i_) { const int xr_ = xrow + 64 * i_; const v4u xs_ = xst[i_]; const float wv_ = WW[xr_]; v4u xw_; \
                      xw_.x = cvt2(bflo(xs_.x) * wv_, bfhi(xs_.x) * wv_); xw_.y = cvt2(bflo(xs_.y) * wv_, bfhi(xs_.y) * wv_); xw_.z = cvt2(bflo(xs_.z) * wv_, bfhi(xs_.z) * wv_); xw_.w = cvt2(bflo(xs_.w) * wv_, bfhi(xs_.w) * wv_); \
                      *(LAS v4u*)(Xs + xr_ * XSt + xc8 * 16) = xs_; *(LAS v4u*)(XWs + xr_ * XSt + xc8 * 16) = xw_; } } while (0)
                __syncthreads();
                SSD_ZLOAD(zr, 0);
                SSD_LOAD(0);
                for (int q = tid; q < 64 * RS / 4; q += 512) ((LAS unsigned*)S16)[q] = 0u;
                SSD_WRITE();
                __syncthreads();
                for (int c = 0; c < 32; ++c) {
                    const size_t t0 = (size_t)b * SEQ + (size_t)c * 128;
                    SSD_OPAQUE();
                    if (c + 1 < 32) { SSD_ZLOAD(zn, c + 1); SSD_LOAD(c + 1); }
                    f32x4 yo[4], yd[4];
#pragma unroll
                    for (int pt = 0; pt < 4; ++pt) { yo[pt] = (f32x4){0.f, 0.f, 0.f, 0.f}; yd[pt] = yo[pt]; }
#pragma unroll
                    for (int ks = 0; ks < 4; ++ks) { const bf16x8 a = *(const LAS bf16x8*)(Cs + (16 * wave + l15) * RS + (ks * 32 + 8 * g4) * 2);
#pragma unroll
                        for (int pt = 0; pt < 4; ++pt) { const bf16x8 bb = *(const LAS bf16x8*)(S16 + (16 * pt + l15) * RS + (ks * 32 + 8 * g4) * 2); yo[pt] = SSD_MFMA16(a, bb, yo[pt]); } }
                    const int st = wave >> 1; f32x16 pg[2];
#pragma unroll
                    for (int j = 0; j < 2; ++j) { const int lt = 2 * (wave & 1) + j;
#pragma unroll
                        for (int r = 0; r < 16; ++r) pg[j][r] = 0.f;
                        if (lt >= st) {
#pragma unroll
                            for (int kk = 0; kk < 8; ++kk) { const bf16x8 a = *(const LAS bf16x8*)(Bs + (32 * st + r32) * RS + (kk * 16 + 8 * hi5) * 2), bb = *(const LAS bf16x8*)(Cs + (32 * lt + r32) * RS + (kk * 16 + 8 * hi5) * 2);
                                pg[j] = __builtin_amdgcn_mfma_f32_32x32x16_bf16(a, bb, pg[j], 0, 0, 0); } } }
                    LDS_BARRIER();
#pragma unroll
                    for (int j = 0; j < 2; ++j) { const int lt = 2 * (wave & 1) + j; const int l = 32 * lt + r32;
                        if (lt >= st) { const float acl = A2[l];
#pragma unroll
                            for (int rg = 0; rg < 4; ++rg) { const int sb = 32 * st + 8 * rg + 4 * hi5; const f32x4 lw = *(const LAS f32x4*)(LW2 + sb);
                                float m[4];
#pragma unroll
                                for (int i = 0; i < 4; ++i) { m[i] = pg[j][4 * rg + i] * __builtin_amdgcn_exp2f(acl + lw[i]); if (lt == st && sb + i > l) m[i] = 0.f; }
                                v2u w; w.x = cvt2(m[0], m[1]); w.y = cvt2(m[2], m[3]); *(LAS v2u*)(Ms + l * RS + sb * 2) = w; } } }
                    LDS_BARRIER();
#pragma unroll
                    for (int ks = 0; ks < 4; ++ks) { if (32 * ks <= 16 * wave + 15) { const bf16x8 a = *(const LAS bf16x8*)(Ms + (16 * wave + l15) * RS + (ks * 32 + 8 * g4) * 2);
#pragma unroll
                        for (int pt = 0; pt < 4; ++pt) { LAS unsigned char* xa = Xs + (ks * 32 + 8 * g4 + trq) * XSt + (16 * pt + 4 * trp) * 2; const v4i16_t lo = SSD_TR(xa), hh = SSD_TR(xa + 4 * XSt);
                            const bf16x8 bb = {lo[0], lo[1], lo[2], lo[3], hh[0], hh[1], hh[2], hh[3]}; yd[pt] = SSD_MFMA16(a, bb, yd[pt]); } } }
                    { const f32x4 acv = *(const LAS f32x4*)(A2 + 16 * wave + 4 * g4); float sq[4] = {0.f, 0.f, 0.f, 0.f};
                      char* op = (char*)(AB + t0 * 4096 + chx);
                      unsigned short xr[16];
#pragma unroll
                      for (int r = 0; r < 4; ++r)
#pragma unroll
                          for (int pt = 0; pt < 4; ++pt) xr[r * 4 + pt] = *(const LAS bf16*)(Xs + (16 * wave + 4 * g4 + r) * XSt + (16 * pt + l15) * 2);
#pragma unroll
                      for (int r = 0; r < 4; ++r) { const float ea = __builtin_amdgcn_exp2f(acv[r]);
#pragma unroll
                          for (int pt = 0; pt < 4; ++pt) {
                              const float xv = bf2f(xr[r * 4 + pt]);
                              const float y = yd[pt][r] + ea * yo[pt][r] + Dh * xv;
                              const float gv = y * siluf_(bf2f(zr[pt * 4 + r])); sq[r] += gv * gv;
                              *(bf16*)(op + (r * 8192 + 32 * pt) + ovo) = (bf16)(cvt2(gv * nwv[pt], 0.f) & 0xffffu); } }
                      { const float s0 = row16_sum(sq[0]), s1 = row16_sum(sq[1]), s2 = row16_sum(sq[2]), s3 = row16_sum(sq[3]);
                        if (l15 < 4) *(float*)((char*)(SS + t0 * 32 + h) + svo) = l15 == 0 ? s0 : l15 == 1 ? s1 : l15 == 2 ? s2 : s3; } }
                    { const float cd = __expf(tot_cur);
#pragma unroll
                      for (int pt = 0; pt < 4; ++pt) Sacc[pt] = Sacc[pt] * cd;
#pragma unroll
                      for (int ks = 0; ks < 4; ++ks) { LAS unsigned char* ba = Bs + (ks * 32 + 8 * g4 + trq) * RS + (16 * wave + 4 * trp) * 2; const v4i16_t bl = SSD_TR(ba), bh = SSD_TR(ba + 4 * RS);
                          const bf16x8 bb = {bl[0], bl[1], bl[2], bl[3], bh[0], bh[1], bh[2], bh[3]};
#pragma unroll
                          for (int pt = 0; pt < 4; ++pt) { LAS unsigned char* xa = XWs + (ks * 32 + 8 * g4 + trq) * XSt + (16 * pt + 4 * trp) * 2; const v4i16_t al = SSD_TR(xa), ahh = SSD_TR(xa + 4 * XSt);
                              const bf16x8 aa = {al[0], al[1], al[2], al[3], ahh[0], ahh[1], ahh[2], ahh[3]}; Sacc[pt] = SSD_MFMA16(aa, bb, Sacc[pt]); } }
#pragma unroll
                      for (int pt = 0; pt < 4; ++pt)
#pragma unroll
                          for (int r = 0; r < 4; ++r) *(LAS bf16*)(S16 + (16 * pt + 4 * g4 + r) * RS + (16 * wave + l15) * 2) = (bf16)(cvt2(Sacc[pt][r], 0.f) & 0xffffu); }
                    LDS_BARRIER();
                    if (c + 1 < 32) { SSD_WRITE();
#pragma unroll
                        for (int i = 0; i < 16; ++i) zr[i] = zn[i]; }
                    LDS_BARRIER();
                }
            }
#undef SSD_LOAD
#undef SSD_OPAQUE
#undef SSD_ZLOAD
#undef SSD_WRITE
#undef SSD_TR
#undef SSD_MFMA16
            __syncthreads();
        }
        if (sub & 1) att::attn_phase((char*)lds, Qb, Kb, Vb, YF8, CUM, ctl + CW_AQ, ctl + CW_QM, ctl + CW_KM, bx & 7, (sub >> 8) & 3);
        if (sub & 4) { __syncthreads(); EXPERT_CONVERT_DYN(ctl + CW_CQ, CONV_P3_END); __syncthreads(); }
    }
    SEAM(3);

    if (IN(4)) {
        { pg8::Shape g{2048, 4096, 4096};
          pg8::SchedPlain S{(const char*)AB, (const char*)WabT, T / 256, 2048 / 256, G, bx, (size_t)256 * 4096 * 2, (size_t)256 * 4096 * 2};
          pg8::EpiMixA E{Gb, SS, PART, (LAS float*)(ldsl + pg8::STAGE_BYTES)};
          pg8::gemm_phase<pg8::EpiMixA, pg8::SchedPlain, true>(ldsl, g, S, E); }
        __syncthreads();
        { pg8::Shape g{1024, 1024, 1024};
          pg8::SchedPlain S{(const char*)YF8, (const char*)WB8, T / 256, 2048 / 256, G, bx, (size_t)256 * 2048, (size_t)256 * 2048};
          pg8::EpiMixB E{Gb, PART, MIX, 1.0f / (WGU_PRESCALE * YF_SCALE)};
          pg8::gemm_phase<pg8::EpiMixB, pg8::SchedPlain, true, false, true>(ldsl, g, S, E); }
    }
    SEAM(4);

    if (IN(5)) {
        pg8::Shape g{2048, 2048, 2048};
        pg8::SchedPlain S{(const char*)MIX, (const char*)WoT, T / 256, 2048 / 256, G, bx, (size_t)256 * 2048 * 2, (size_t)256 * 2048 * 2};
        pg8::EpiRes E{in_x, Hf};
        pg8::gemm_phase<pg8::EpiRes, pg8::SchedPlain, true>(ldsl, g, S, E);
    }
    SEAM(5);

    if (IN(6)) {
        for (int q = bx * 512 + tid; q < MAXROWS; q += G * 512) row_tok[q] = -1;
        if (sub & 8) {
            constexpr int UST = 136;
            LAS bf16* Uhi = (LAS bf16*)(ldsl); LAS bf16* Ulo = Uhi + 64 * UST; LAS bf16* Whi = Ulo + 64 * UST; LAS bf16* Wlo = Whi + 80 * UST;
            LAS float* RS = (LAS float*)(ldsl + 81920); LAS float* LG = (LAS float*)(ldsl + 82944);
            LAS unsigned* LCNT = (LAS unsigned*)(ldsl + 104448); LAS unsigned* LBASE = LCNT + 64;
            for (int tb = bx; tb < T / 64; tb += G) {
                const int t0 = tb * 64;
                __syncthreads();
                if (tid < 64) LCNT[tid] = 0u;
                v4u hrw[8][4];
#pragma unroll
                for (int q = 0; q < 8; ++q) { const v4u* hr = (const v4u*)(Hf + (size_t)(t0 + wave * 8 + q) * DM);
#pragma unroll
                    for (int j = 0; j < 4; ++j) hrw[q][j] = hr[j * 64 + lane]; }
#pragma unroll
                for (int q = 0; q < 8; ++q) { const int tk = wave * 8 + q; float s = 0.f;
#pragma unroll
                    for (int j = 0; j < 4; ++j) { const v4u v = hrw[q][j]; const float a0 = bflo(v.x), a1 = bfhi(v.x), a2 = bflo(v.y), a3 = bfhi(v.y), a4 = bflo(v.z), a5 = bfhi(v.z), a6 = bflo(v.w), a7 = bfhi(v.w);
                        s += ((a0 * a0 + a1 * a1) + (a2 * a2 + a3 * a3)) + ((a4 * a4 + a5 * a5) + (a6 * a6 + a7 * a7)); }
                    s = wave_sum(s); if (lane == 0) RS[tk] = 1.0f / sqrtf(s * (1.f / DM) + EPS); }
                f32x4 acc[3];
#pragma unroll
                for (int i = 0; i < 3; ++i) acc[i] = (f32x4){0.f, 0.f, 0.f, 0.f};
                v4u hq0[2], hq1[2], wq[2][6]; f32x4 nwq[2][4];
                const int ptk = tid >> 3, pkq = (tid & 7) * 16;
#define RT_LOAD(S_, kc_) do { const int k0_ = (kc_) * 128; const v4u* hp_ = (const v4u*)(Hf + (size_t)(t0 + ptk) * DM + k0_ + pkq); hq0[S_] = hp_[0]; hq1[S_] = hp_[1]; \
                    const f32x4* wp_ = (const f32x4*)(norm_moe_w + k0_ + pkq); nwq[S_][0] = wp_[0]; nwq[S_][1] = wp_[1]; nwq[S_][2] = wp_[2]; nwq[S_][3] = wp_[3]; \
                    _Pragma("unroll") for (int i_ = 0; i_ < 3; ++i_) { const int q_ = tid + 512 * i_; if (q_ < 80 * 16) { const int r_ = q_ >> 4, c_ = (q_ & 15) * 8; \
                        wq[S_][2 * i_] = *(const v4u*)(WrHi + (size_t)r_ * 2048 + k0_ + c_); wq[S_][2 * i_ + 1] = *(const v4u*)(WrLo + (size_t)r_ * 2048 + k0_ + c_); } } } while (0)
                RT_LOAD(0, 0); RT_LOAD(1, 1);
                for (int kc2 = 0; kc2 < 16; kc2 += 2) {
#pragma unroll
                  for (int par = 0; par < 2; ++par) {
                    const int kc = kc2 + par, k0 = kc * 128;
                    LDS_BARRIER();
                    { const int tk = ptk, kq = pkq; const float rs = RS[tk];
                      const f32x4 hv[4] = {(f32x4){bflo(hq0[par].x), bfhi(hq0[par].x), bflo(hq0[par].y), bfhi(hq0[par].y)}, (f32x4){bflo(hq0[par].z), bfhi(hq0[par].z), bflo(hq0[par].w), bfhi(hq0[par].w)},
                                           (f32x4){bflo(hq1[par].x), bfhi(hq1[par].x), bflo(hq1[par].y), bfhi(hq1[par].y)}, (f32x4){bflo(hq1[par].z), bfhi(hq1[par].z), bflo(hq1[par].w), bfhi(hq1[par].w)}};
                      unsigned hw[8], lw[8], f8w[4];
#pragma unroll
                      for (int j = 0; j < 4; ++j) { const f32x4 u = hv[j] * rs * nwq[par][j]; f8w[j] = cvt_fp8x4(u[0], u[1], u[2], u[3]);
                          const unsigned h0 = f2bf(u[0]), h1 = f2bf(u[1]), h2 = f2bf(u[2]), h3 = f2bf(u[3]);
                          hw[2 * j] = h0 | (h1 << 16); hw[2 * j + 1] = h2 | (h3 << 16);
                          lw[2 * j] = pk2(u[0] - bf2f(h0), u[1] - bf2f(h1)); lw[2 * j + 1] = pk2(u[2] - bf2f(h2), u[3] - bf2f(h3)); }
                      const v4u H0 = {hw[0], hw[1], hw[2], hw[3]}, H1 = {hw[4], hw[5], hw[6], hw[7]}, L0 = {lw[0], lw[1], lw[2], lw[3]}, L1 = {lw[4], lw[5], lw[6], lw[7]};
                      *(LAS v4u*)(Uhi + tk * UST + kq) = H0; *(LAS v4u*)(Uhi + tk * UST + kq + 8) = H1;
                      *(LAS v4u*)(Ulo + tk * UST + kq) = L0; *(LAS v4u*)(Ulo + tk * UST + kq + 8) = L1;
                      *(v4u*)((unsigned char*)U2 + (size_t)(t0 + tk) * DM + k0 + kq) = (v4u){f8w[0], f8w[1], f8w[2], f8w[3]}; }
#pragma unroll
                    for (int i = 0; i < 3; ++i) { const int q = tid + 512 * i; if (q < 80 * 16) { const int r = q >> 4, c = (q & 15) * 8;
                        *(LAS v4u*)(Whi + r * UST + c) = wq[par][2 * i]; *(LAS v4u*)(Wlo + r * UST + c) = wq[par][2 * i + 1]; } }
                    if (kc + 2 < 16) RT_LOAD(par, kc + 2);
                    LDS_BARRIER();
#pragma unroll
                    for (int i = 0; i < 3; ++i) { const int tile = wave + 8 * i;
                        if (tile < 20) { const int tt = tile / 5, ct = tile - tt * 5;
#pragma unroll
                            for (int ks = 0; ks < 4; ++ks) { const int ko = ks * 32 + 8 * (lane >> 4);
                                const bf16x8 ah = *(const LAS bf16x8*)(Uhi + (tt * 16 + (lane & 15)) * UST + ko), al = *(const LAS bf16x8*)(Ulo + (tt * 16 + (lane & 15)) * UST + ko);
                                const bf16x8 bh = *(const LAS bf16x8*)(Whi + (ct * 16 + (lane & 15)) * UST + ko), bl = *(const LAS bf16x8*)(Wlo + (ct * 16 + (lane & 15)) * UST + ko);
                                acc[i] = __builtin_amdgcn_mfma_f32_16x16x32_bf16(ah, bh, acc[i], 0, 0, 0);
                                acc[i] = __builtin_amdgcn_mfma_f32_16x16x32_bf16(al, bh, acc[i], 0, 0, 0);
                                acc[i] = __builtin_amdgcn_mfma_f32_16x16x32_bf16(ah, bl, acc[i], 0, 0, 0); } } }
                  }
                }
#pragma unroll
                for (int i = 0; i < 3; ++i) { const int tile = wave + 8 * i;
                    if (tile < 20) { const int tt = tile / 5, ct = tile - tt * 5;
#pragma unroll
                        for (int r = 0; r < 4; ++r) LG[(tt * 16 + (lane >> 4) * 4 + r) * 80 + ct * 16 + (lane & 15)] = acc[i][r]; } }
                __syncthreads();
                int e0 = 0, e1 = 0; unsigned lr0 = 0, lr1 = 0;
                if (tid < 64) {
                    const LAS float* lg = LG + tid * 80; float gl[8]; float gm = -3.0e38f; int gi = 0;
#pragma unroll
                    for (int j = 0; j < 8; ++j) { gl[j] = lg[j] + b_rg[j]; if (gl[j] > gm) { gm = gl[j]; gi = j; } }
                    float gs = 0.f;
#pragma unroll
                    for (int j = 0; j < 8; ++j) gs += __expf(gl[j] - gm);
                    const float gp = 1.0f / gs;
                    float el[8]; float m0 = -3.0e38f, m1 = -3.0e38f; int i0 = 0, i1 = 0;
#pragma unroll
                    for (int j = 0; j < 8; ++j) { el[j] = lg[8 + gi * 8 + j] + b_re[gi * 8 + j]; }
#pragma unroll
                    for (int j = 0; j < 8; ++j) { if (el[j] > m0) { m1 = m0; i1 = i0; m0 = el[j]; i0 = j; } else if (el[j] > m1) { m1 = el[j]; i1 = j; } }
                    const float x1 = __expf(m1 - m0), den = 1.0f / (1.0f + x1);
                    e0 = gi * 8 + i0; e1 = gi * 8 + i1;
                    tok_e[(t0 + tid) * 2] = e0; tok_e[(t0 + tid) * 2 + 1] = e1;
                    tok_w[(t0 + tid) * 2] = gp * den; tok_w[(t0 + tid) * 2 + 1] = gp * x1 * den;
                    lr0 = __hip_atomic_fetch_add(LCNT + e0, 1u, __ATOMIC_RELAXED, __HIP_MEMORY_SCOPE_WORKGROUP);
                    lr1 = __hip_atomic_fetch_add(LCNT + e1, 1u, __ATOMIC_RELAXED, __HIP_MEMORY_SCOPE_WORKGROUP);
                }
                __syncthreads();
                if (tid < 64) { const unsigned c = LCNT[tid]; LBASE[tid] = c ? __hip_atomic_fetch_add(ecnt + tid, c, RLX_AGENT) : 0u; }
                __syncthreads();
                if (tid < 64) { tok_rank[(t0 + tid) * 2] = (int)(LBASE[e0] + lr0); tok_rank[(t0 + tid) * 2 + 1] = (int)(LBASE[e1] + lr1); }
            }
            __syncthreads();
        }
    }
    SEAM(6);

    if (IN(7)) {
        LAS unsigned* PST = (LAS unsigned*)(ldsl);
        if (tid < 64) {
            const unsigned pad = ((ld_ctl(ecnt + tid) + 255u) >> 8) << 8; unsigned incl = pad;
#pragma unroll
            for (int o = 1; o < 64; o <<= 1) { const unsigned n = __shfl_up(incl, o); if (lane >= o) incl += n; }
            PST[tid] = incl - pad; if (tid == 63) PST[NEXP] = incl;
            if (bx == 0) { const unsigned first = (incl - pad) >> 8, n = pad >> 8; for (unsigned q = 0; q < n; ++q) tile_tab[16 + first + q] = (unsigned)tid; if (tid == 63) tile_tab[0] = incl >> 8; } }
        __syncthreads();
        for (int sl = bx * 512 + tid; sl < T * 2; sl += G * 512) { const int row = (int)PST[tok_e[sl]] + tok_rank[sl]; tok_row[sl] = row; row_tok[row] = sl >> 1; }
        __syncthreads();
    }
    SEAM(7);

    if (IN(8)) {
        const int ntiles = (int)ld_ctl(tile_tab);
        LAS unsigned* ltab = (LAS unsigned*)(ldsl + LTAB_OFF);
        if (tid < 256) ltab[tid] = tid < ntiles ? ld_ctl(tile_tab + 16 + tid) : 0u;
        __syncthreads();
        pg8::Shape g{1024, 1024, 1024};
        pg8::SchedMoe S{(const char*)U2, (const char*)WguT, (const char*)WguT, 64, ltab, row_tok, ntiles, 4, G, bx, (size_t)0, (size_t)1024 * 2048, (size_t)256 * 2048};
        pg8::EpiGU E{HDN, 1.0f / WGU_PRESCALE};
        pg8::gemm_phase<pg8::EpiGU, pg8::SchedMoe, true, true, true>(ldsl, g, S, E);
        { const int vbx = (G % 8 == 0) ? (bx % 8) * (G / 8) + bx / 8 : bx;
          const int rem = (ntiles * 4) % G; const bool all = rem == 0; const int nconv = all ? G : G - rem, crank = all ? vbx : vbx - rem;
            if (all || vbx >= rem) { __syncthreads(); EXPERT_CONVERT_S(2 * CONV_I_G + WD_SPLIT * 256, 2 * CONV_I_G + NEXP * 256, crank * 8 + wave, nconv * 8); __syncthreads(); } }
    }
    SEAM(8);

    if (IN(9)) {
        const int ntiles = (int)ld_ctl(tile_tab);
        LAS unsigned* ltab = (LAS unsigned*)(ldsl + LTAB_OFF);
        if (tid < 256) ltab[tid] = tid < ntiles ? ld_ctl(tile_tab + 16 + tid) : 0u;
        __syncthreads();
        pg8::Shape g{256, 256, 256};
        pg8::SchedMoe S{(const char*)HDN, (const char*)WdA, (const char*)WdB, WD_SPLIT, ltab, row_tok, ntiles, 8, G, bx, (size_t)256 * 512, (size_t)2048 * 512, (size_t)256 * 512};
        pg8::EpiPlain E{(unsigned char*)YM, 2048, 1.0f / WGU_PRESCALE};
        pg8::gemm_phase<pg8::EpiPlain, pg8::SchedMoe, true, false, true>(ldsl, g, S, E);
    }
    SEAM(9);

    if (IN(10)) {
        { v4u hq[2][4]; v2u ya[2][4], yb[2][4]; float w0[2], w1[2]; int rn0 = 0, rn1 = 0; float wn0 = 0.f, wn1 = 0.f;
#define P10_IDX(m_) do { rn0 = tok_row[(m_) * 2]; rn1 = tok_row[(m_) * 2 + 1]; wn0 = tok_w[(m_) * 2]; wn1 = tok_w[(m_) * 2 + 1]; } while (0)
#define P10_LOAD(S_, m_) do { const int r0_ = rn0, r1_ = rn1; w0[S_] = wn0; w1[S_] = wn1; \
            const v4u* hr_ = (const v4u*)(Hf + (size_t)(m_) * DM); const v2u* y0_ = (const v2u*)((const unsigned char*)YM + (size_t)r0_ * DM); const v2u* y1_ = (const v2u*)((const unsigned char*)YM + (size_t)r1_ * DM); \
            _Pragma("unroll") for (int j_ = 0; j_ < 4; ++j_) { const int ci_ = j_ * 64 + lane; hq[S_][j_] = __builtin_nontemporal_load(hr_ + ci_); ya[S_][j_] = __builtin_nontemporal_load(y0_ + ci_); yb[S_][j_] = __builtin_nontemporal_load(y1_ + ci_); } } while (0)
          int m = gw; if (m < T) { P10_IDX(m); P10_LOAD(0, m); if (m + NGW < T) P10_IDX(m + NGW); }
          for (int it = 0; m < T; m += NGW, ++it) {
#pragma unroll
            for (int par = 0; par < 2; ++par) { if ((it & 1) == par) {
              if (m + NGW < T) { P10_LOAD(par ^ 1, m + NGW); if (m + 2 * NGW < T) P10_IDX(m + 2 * NGW); }
              f32x4 v[8]; float sacc = 0.f;
#pragma unroll
              for (int j = 0; j < 4; ++j) { const v2u a = ya[par][j], bq = yb[par][j]; const v4u hh = hq[par][j];
                  const f32x4 ha = (f32x4){bflo(hh.x), bfhi(hh.x), bflo(hh.y), bfhi(hh.y)}, hb = (f32x4){bflo(hh.z), bfhi(hh.z), bflo(hh.w), bfhi(hh.w)};
                  v[2 * j] = ha + fp8x4_to_f32(a.x) * w0[par] + fp8x4_to_f32(bq.x) * w1[par];
                  v[2 * j + 1] = hb + fp8x4_to_f32(a.y) * w0[par] + fp8x4_to_f32(bq.y) * w1[par]; }
#pragma unroll
              for (int j = 0; j < 8; ++j) sacc += (v[j][0] * v[j][0] + v[j][1] * v[j][1]) + (v[j][2] * v[j][2] + v[j][3] * v[j][3]);
              const float rstd = 1.0f / sqrtf(wave_sum(sacc) * (1.f / DM) + EPS);
              f32x4* op = (f32x4*)(args.out + (size_t)m * DM); const f32x4* wp = (const f32x4*)norm_final_w;
#pragma unroll
              for (int j = 0; j < 4; ++j) { const int ci = j * 64 + lane; op[ci * 2] = v[2 * j] * rstd * wp[ci * 2]; op[ci * 2 + 1] = v[2 * j + 1] * rstd * wp[ci * 2 + 1]; }
            } }
          }
#undef P10_LOAD
#undef P10_IDX
        }
    }
#undef IN
#undef SEAM
}

extern "C" void kernel_launch(void* const* d_in, const int* in_sizes, int n_in, void* d_out, int out_size, void* d_ws, size_t ws_size, hipStream_t stream) {
    static int grid = 0;
    if (grid == 0) {
        if (n_in != 22 || out_size != T * DM || ws_size < WS_END) { fprintf(stderr, "kernel_launch: unexpected shapes (n_in %d out %d ws %zu)\n", n_in, out_size, ws_size); grid = -1; return; }
        int dev = 0, cus = 0;
        if (hipGetDevice(&dev) != hipSuccess || hipDeviceGetAttribute(&cus, hipDeviceAttributeMultiprocessorCount, dev) != hipSuccess) { grid = -1; return; }
        if (hipFuncSetAttribute((const void*)mega_fwd, hipFuncAttributeMaxDynamicSharedMemorySize, LDS_BYTES) != hipSuccess) { fprintf(stderr, "kernel_launch: hipFuncSetAttribute failed\n"); grid = -1; return; }
        int per_cu = 0;
        if (hipOccupancyMaxActiveBlocksPerMultiprocessor(&per_cu, (const void*)mega_fwd, 512, LDS_BYTES) != hipSuccess || per_cu < 1) fprintf(stderr, "kernel_launch: occupancy query says %d\n", per_cu);
        (void)hipGetLastError();
        grid = cus > 0 ? cus : 256;
    }
    if (grid < 0) return;
    (void)hipMemsetAsync((char*)d_ws + WS_CTL, 0, CTL_ZERO_BYTES, stream);
    Args a{};
    for (int i = 0; i < 22; ++i) a.in[i] = (const float*)d_in[i];
    a.out = (float*)d_out; a.ws = (unsigned char*)d_ws; a.sub = 15;
#if N_LAUNCH_MODE == 1
    a.ph_lo = 0; a.ph_hi = NPHASE;
    hipLaunchKernelGGL(mega_fwd, dim3(grid), dim3(512), LDS_BYTES, stream, a);
#else
    for (int p = 0; p < NPHASE; ++p) { a.ph_lo = p; a.ph_hi = p + 1; a.sub = 15; hipLaunchKernelGGL(mega_fwd, dim3(grid), dim3(512), LDS_BYTES, stream, a);
#ifdef PROBE_PH
        if (p == PROBE_PH) { a.sub = PROBE_SUB; for (int r = 0; r < PROBE_REP; ++r) hipLaunchKernelGGL(mega_fwd, dim3(grid), dim3(512), LDS_BYTES, stream, a); }
#endif
    }
#endif
}
```
